# Optimizing an MI355X kernel written in HIP

```python
import jax, jax.numpy as jnp
from jax import lax
import numpy as np

D_MODEL = 1024
BATCH = 16
SEQ = 2048
DEPTH = 2
DEC_BATCH = 128
DEC_SEQ = 1
PAST_LEN = 16384
PAGE_SIZE = 128

LRU_WIDTH = D_MODEL
LRU_BLOCKS = 16
LRU_BLOCK = LRU_WIDTH // LRU_BLOCKS
CONV_W = 4
LRU_C = 8.0
N_HEADS = 16
N_KV = 4
HEAD_DIM = D_MODEL // N_HEADS
GROUP = N_HEADS // N_KV
WINDOW = 128
Q_W = N_HEADS * HEAD_DIM
KV_W = N_KV * HEAD_DIM
N_MEM = 256
N_XHEADS = 4
XHEAD_DIM = D_MODEL // N_XHEADS
XW = N_XHEADS * XHEAD_DIM
N_BRANCH = 3
D_FF = -(-8 * D_MODEL // (3 * 256)) * 256
LN_EPS = 1e-5
ALPHA = (2 * DEPTH) ** 0.25
BETA = (8 * DEPTH) ** -0.25
COL_WIDTHS = (LRU_WIDTH, LRU_WIDTH, Q_W, KV_W, KV_W, XW, N_BRANCH * D_MODEL)
SPLIT_IDX = [int(c) for c in np.cumsum(COL_WIDTHS)[:-1]]
IN_COLS = int(sum(COL_WIDTHS))

kernel_name = "hybrid_rglru_swa_memxattn_decode_step"


def layer_norm(x, g, b):
    xf = x.astype(jnp.float32)
    mu = xf.mean(-1, keepdims=True)
    var = jnp.square(xf - mu).mean(-1, keepdims=True)
    y = (xf - mu) * lax.rsqrt(var + LN_EPS) * g.astype(jnp.float32) + b.astype(jnp.float32)
    return y.astype(x.dtype)


def causal_conv(xb, buf, w, b):
    T = xb.shape[1]
    xc = jnp.concatenate([buf, xb], axis=1)
    y = b + sum(xc[:, k:k + T] * w[k] for k in range(CONV_W))
    return y, xc[:, -(CONV_W - 1):]


def rg_lru(xc, h0, wa, ba, wx, bx, lam):
    B, T, C = xc.shape
    f32 = jnp.float32
    xf = xc.astype(f32)
    xblk = xf.reshape(B, T, LRU_BLOCKS, LRU_BLOCK)
    r = jax.nn.sigmoid(jnp.einsum('btni,nij->btnj', xblk, wa.astype(f32)).reshape(B, T, C) + ba.astype(f32))
    i = jax.nn.sigmoid(jnp.einsum('btni,nij->btnj', xblk, wx.astype(f32)).reshape(B, T, C) + bx.astype(f32))
    log_a = -LRU_C * r * jax.nn.softplus(-lam.astype(f32))
    a = jnp.exp(log_a)
    u = jnp.sqrt(-jnp.expm1(2.0 * log_a)) * (i * xf)

    def step(h, au):
        a_t, u_t = au
        h = a_t * h + u_t
        return h, h

    hT, hs = lax.scan(step, h0.astype(f32), (jnp.swapaxes(a, 0, 1), jnp.swapaxes(u, 0, 1)))
    return jnp.swapaxes(hs, 0, 1).astype(xc.dtype), hT.astype(h0.dtype)


def sink_softmax(s, mask, sinks):
    sk = sinks.astype(jnp.float32).reshape(N_KV, GROUP)[..., None, None]
    s = jnp.where(mask, s, -1e30)
    mx = jnp.maximum(s.max(-1, keepdims=True), sk)
    e = jnp.exp(s - mx)
    return e / (e.sum(-1, keepdims=True) + jnp.exp(sk - mx))


def band_mask(nq, nk_prefix):
    qi = jnp.arange(nq)[:, None]
    m = jnp.arange(nk_prefix + nq)[None, :]
    return (m <= qi + nk_prefix) & (m > qi + nk_prefix - WINDOW)


def swa_prompt(q, k, v, sinks):
    B, T = q.shape[:2]
    nb = T // WINDOW
    scale = HEAD_DIM ** -0.5
    qb = q.reshape(B, nb, WINDOW, N_KV, GROUP, HEAD_DIM)
    kb = k.reshape(B, nb, WINDOW, N_KV, HEAD_DIM)
    vb = v.reshape(B, nb, WINDOW, N_KV, HEAD_DIM)
    pad = ((0, 0), (1, 0), (0, 0), (0, 0), (0, 0))
    kband = jnp.concatenate([jnp.pad(kb[:, :-1], pad), kb], axis=2)
    vband = jnp.concatenate([jnp.pad(vb[:, :-1], pad), vb], axis=2)
    s = jnp.einsum('bnqkgd,bnmkd->bnkgqm', qb, kband).astype(jnp.float32) * scale
    band = band_mask(WINDOW, WINDOW)
    m = jnp.arange(2 * WINDOW)[None, :]
    real = (jnp.arange(nb)[:, None, None] > 0) | (m >= WINDOW)[None]
    mask = (band[None] & real)[None, :, None, None]
    p = sink_softmax(s, mask, sinks).astype(v.dtype)
    o = jnp.einsum('bnkgqm,bnmkd->bnqkgd', p, vband)
    return o.reshape(B, T, Q_W)


def swa_decode(q, k, v, win_k, win_v, sinks):
    B, T = q.shape[:2]
    scale = HEAD_DIM ** -0.5
    kall = jnp.concatenate([win_k, k], axis=1)
    vall = jnp.concatenate([win_v, v], axis=1)
    qg = q.reshape(B, T, N_KV, GROUP, HEAD_DIM)
    s = jnp.einsum('btkgd,bmkd->bkgtm', qg, kall).astype(jnp.float32) * scale
    p = sink_softmax(s, band_mask(T, WINDOW), sinks).astype(v.dtype)
    o = jnp.einsum('bkgtm,bmkd->btkgd', p, vall)
    return o.reshape(B, T, Q_W), kall[:, -WINDOW:], vall[:, -WINDOW:]


def mem_attn(q, mk, mv):
    s = jnp.einsum('bthd,bmhd->bhtm', q, mk).astype(jnp.float32) * (XHEAD_DIM ** -0.5)
    p = jax.nn.softmax(s, axis=-1).astype(mv.dtype)
    B, T = q.shape[:2]
    return jnp.einsum('bhtm,bmhd->bthd', p, mv).reshape(B, T, XW)


def decoder_layer(x, conv_buf, h0, win_k, win_v, mem_k, mem_v, is_prompt, lw):
    (w_in, b_gates, conv_w, conv_b, lru_wa, lru_ba, lru_wx, lru_bx, lru_lambda, sinks,
     w_branch, w_out, ln1_g, ln1_b, w_gate_up, w_down, ln2_g, ln2_b) = lw
    B, T, _ = x.shape
    z = x @ w_in
    xr, yr, q, k, v, xq, g = jnp.split(z, SPLIT_IDX, axis=-1)
    xc, conv_new = causal_conv(xr, conv_buf, conv_w, conv_b)
    hs, h_new = rg_lru(xc, h0, lru_wa, lru_ba, lru_wx, lru_bx, lru_lambda)
    a_out = hs * jax.nn.gelu(yr, approximate=True)
    q = q.reshape(B, T, N_HEADS, HEAD_DIM)
    k = k.reshape(B, T, N_KV, HEAD_DIM)
    v = v.reshape(B, T, N_KV, HEAD_DIM)
    if is_prompt:
        s_out = swa_prompt(q, k, v, sinks)
        wk_new, wv_new = k[:, -WINDOW:], v[:, -WINDOW:]
    else:
        s_out, wk_new, wv_new = swa_decode(q, k, v, win_k, win_v, sinks)
    c_out = mem_attn(xq.reshape(B, T, N_XHEADS, XHEAD_DIM), mem_k, mem_v)
    gates = jax.nn.sigmoid(g.reshape(B, T, N_BRANCH, D_MODEL) + b_gates)
    merged = sum(gates[:, :, n] * (br @ w_branch[n]) for n, br in enumerate((a_out, s_out, c_out)))
    h = layer_norm(ALPHA * x + merged @ w_out, ln1_g, ln1_b)
    gt, up = jnp.split(h @ w_gate_up, 2, axis=-1)
    h = layer_norm(ALPHA * h + (jax.nn.silu(gt) * up) @ w_down, ln2_g, ln2_b)
    return h, conv_new, h_new, wk_new, wv_new


def setup_inputs(seed: int = 0) -> dict:
    key = jax.random.key(seed)
    ks = iter(jax.random.split(key, 40))
    nrm = lambda shape, s=1.0: jax.random.normal(next(ks), shape, jnp.float32) * s
    L = DEPTH
    a_init = jax.random.uniform(next(ks), (L, LRU_WIDTH), jnp.float32, 0.9, 0.999)
    return {
        "x_prompt": nrm((BATCH, SEQ, D_MODEL)),
        "x_sample": nrm((DEC_BATCH, DEC_SEQ, D_MODEL)),
        "state_conv": nrm((L, DEC_BATCH, CONV_W - 1, LRU_WIDTH)),
        "state_h": nrm((L, DEC_BATCH, LRU_WIDTH)),
        "cache_win_k": nrm((L, DEC_BATCH, WINDOW, N_KV, HEAD_DIM)),
        "cache_win_v": nrm((L, DEC_BATCH, WINDOW, N_KV, HEAD_DIM)),
        "cache_mem_k": nrm((L, DEC_BATCH, N_MEM, N_XHEADS, XHEAD_DIM)),
        "cache_mem_v": nrm((L, DEC_BATCH, N_MEM, N_XHEADS, XHEAD_DIM)),
        "mem_prompt": nrm((BATCH, N_MEM, D_MODEL)),
        "w_mem_kv": nrm((L, D_MODEL, 2 * XW), D_MODEL ** -0.5),
        "w_in": nrm((L, D_MODEL, IN_COLS), D_MODEL ** -0.5),
        "b_gates": nrm((L, N_BRANCH, D_MODEL), 0.02),
        "conv_w": nrm((L, CONV_W, LRU_WIDTH), CONV_W ** -0.5),
        "conv_b": nrm((L, LRU_WIDTH), 0.02),
        "lru_wa": nrm((L, LRU_BLOCKS, LRU_BLOCK, LRU_BLOCK), LRU_BLOCK ** -0.5),
        "lru_ba": nrm((L, LRU_WIDTH), 0.02),
        "lru_wx": nrm((L, LRU_BLOCKS, LRU_BLOCK, LRU_BLOCK), LRU_BLOCK ** -0.5),
        "lru_bx": nrm((L, LRU_WIDTH), 0.02),
        "lru_lambda": jnp.log(a_init) - jnp.log1p(-a_init),
        "sinks": nrm((L, N_HEADS), 0.5),
        "w_branch": nrm((L, N_BRANCH, D_MODEL, D_MODEL), D_MODEL ** -0.5),
        "w_out": nrm((L, D_MODEL, D_MODEL), BETA * D_MODEL ** -0.5),
        "ln1_g": 1.0 + nrm((L, D_MODEL), 0.02),
        "ln1_b": nrm((L, D_MODEL), 0.02),
        "w_gate_up": nrm((L, D_MODEL, 2 * D_FF), D_MODEL ** -0.5),
        "w_down": nrm((L, D_FF, D_MODEL), BETA * D_FF ** -0.5),
        "ln2_g": 1.0 + nrm((L, D_MODEL), 0.02),
        "ln2_b": nrm((L, D_MODEL), 0.02),
    }


def reference(x_prompt, x_sample, state_conv, state_h, cache_win_k, cache_win_v, cache_mem_k, cache_mem_v,
              mem_prompt, w_mem_kv, w_in, b_gates, conv_w, conv_b, lru_wa, lru_ba, lru_wx, lru_bx, lru_lambda,
              sinks, w_branch, w_out, ln1_g, ln1_b, w_gate_up, w_down, ln2_g, ln2_b):
    xp, xs = x_prompt, x_sample
    Bp = xp.shape[0]
    p_conv, p_h, p_wk, p_wv, p_mk, p_mv = [], [], [], [], [], []
    s_conv, s_h, s_wk, s_wv = [], [], [], []
    zero_conv = jnp.zeros((Bp, CONV_W - 1, LRU_WIDTH), xp.dtype)
    zero_h = jnp.zeros((Bp, LRU_WIDTH), xp.dtype)
    for l in range(DEPTH):
        lw = (w_in[l], b_gates[l], conv_w[l], conv_b[l], lru_wa[l], lru_ba[l], lru_wx[l], lru_bx[l],
              lru_lambda[l], sinks[l], w_branch[l], w_out[l], ln1_g[l], ln1_b[l], w_gate_up[l], w_down[l],
              ln2_g[l], ln2_b[l])
        mkv = (mem_prompt @ w_mem_kv[l]).reshape(Bp, N_MEM, 2, N_XHEADS, XHEAD_DIM)
        mk, mv = mkv[:, :, 0], mkv[:, :, 1]
        xp, c_new, h_new, wk, wv = decoder_layer(xp, zero_conv, zero_h, None, None, mk, mv, True, lw)
        p_conv.append(c_new); p_h.append(h_new); p_wk.append(wk); p_wv.append(wv)
        p_mk.append(mk); p_mv.append(mv)
        xs, c_new, h_new, wk, wv = decoder_layer(xs, state_conv[l], state_h[l], cache_win_k[l], cache_win_v[l],
                                                 cache_mem_k[l], cache_mem_v[l], False, lw)
        s_conv.append(c_new); s_h.append(h_new); s_wk.append(wk); s_wv.append(wv)
    return (xp, xs,
            jnp.stack(p_conv), jnp.stack(p_h), jnp.stack(p_wk), jnp.stack(p_wv), jnp.stack(p_mk), jnp.stack(p_mv),
            jnp.stack(s_conv), jnp.stack(s_h), jnp.stack(s_wk), jnp.stack(s_wv))
```

```cpp
#include <hip/hip_runtime.h>
#include <hip/hip_cooperative_groups.h>
#include <cstdio>
#include <cstdint>
namespace cg = cooperative_groups;

#define DI __device__ __forceinline__
#define LAS __attribute__((address_space(3)))
typedef unsigned short bf16_t;
typedef short bf16x8 __attribute__((ext_vector_type(8)));
typedef short s16x4 __attribute__((ext_vector_type(4)));
typedef float f32x4 __attribute__((ext_vector_type(4)));
typedef float f32x2 __attribute__((ext_vector_type(2)));
typedef unsigned u32x4 __attribute__((ext_vector_type(4)));
typedef unsigned u32x2 __attribute__((ext_vector_type(2)));
typedef __bf16 bf16x2_t __attribute__((ext_vector_type(2)));

DI unsigned pk2(float lo, float hi) { f32x2 v = {lo, hi}; bf16x2_t b = __builtin_convertvector(v, bf16x2_t); return __builtin_bit_cast(unsigned, b); }
DI bf16_t f2bf(float x) { return (bf16_t)(pk2(x, 0.f) & 0xffffu); }
DI float bf2f(bf16_t h) { return __uint_as_float(((unsigned)h) << 16); }
DI float bflo(unsigned w) { return __uint_as_float(w << 16); }
DI float bfhi(unsigned w) { return __uint_as_float(w & 0xffff0000u); }
DI float fexp2(float x) { return __builtin_amdgcn_exp2f(x); }
DI float frcp(float x) { return __builtin_amdgcn_rcpf(x); }
constexpr float LOG2E = 1.4426950408889634f;
DI float sigmoidf_(float x) { return frcp(1.f + fexp2(-x * LOG2E)); }
DI float gelu_tanh(float x) { const float y = 1.5957691216057308f * (x + 0.044715f * x * x * x); return x * sigmoidf_(y); }

constexpr int DM = 1024, NB = 16, SEQ = 2048, NS = 128, MPR = NB * SEQ, MREAL = MPR + NS, MT = 33024, NTM = MT / 256;
constexpr int INC = 7680, DFF = 2816, NMEM = 256;
constexpr float ALPHA = 1.4142135623730951f, LN_EPS = 1e-5f;
constexpr size_t O_YP = 0, O_YS = 33554432, O_PCONV = 33685504, O_PH = 33783808, O_PWK = 33816576, O_PWV = 34865152, O_PMK = 35913728, O_PMV = 44302336,
                 O_SCONV = 52690944, O_SH = 53477376, O_SWK = 53739520, O_SWV = 62128128, O_END = 70516736;
constexpr size_t WS_CTL = 0;
constexpr size_t WS_WIN = 1u << 20;
constexpr size_t WS_WMKV = WS_WIN + 2ull * INC * DM * 2;
constexpr size_t WS_WBR = WS_WMKV + 2ull * 2048 * DM * 2;
constexpr size_t WS_WOUT = WS_WBR + 2ull * 3072 * DM * 2;
constexpr size_t WS_WGU = WS_WOUT + 2ull * DM * DM * 2;
constexpr size_t WS_WDN = WS_WGU + 2ull * 2 * DFF * DM * 2;
constexpr size_t WS_RB = WS_WDN + 2ull * DM * DFF * 2;
constexpr size_t WS_RF = WS_RB + (size_t)MT * DM * 2;
constexpr size_t COLB = (size_t)MT * DM * 2;
constexpr size_t WS_ZYA = WS_RF + (size_t)MT * DM * 4;
constexpr size_t WS_ZQS = WS_ZYA + COLB, WS_ZXC = WS_ZQS + COLB, WS_ZXR = WS_ZXC + COLB, WS_ZKV = WS_ZXR + COLB;
constexpr size_t WS_GT = WS_ZKV + (size_t)MT * 512 * 2;
constexpr size_t WS_MG = WS_GT + (size_t)MT * 3072 * 2;
constexpr size_t WS_VT = WS_MG + COLB;
constexpr size_t WS_MKB = WS_VT + 256ull * MT * 2;
constexpr size_t WS_MVT = WS_MKB + 2ull * 4096 * DM * 2;
constexpr size_t WS_MPB = WS_MVT + 2ull * 4096 * DM * 2;
constexpr size_t WS_END = WS_MPB + 4096ull * DM * 2;
static_assert((size_t)MT * DFF * 2 <= WS_GT - WS_ZYA, "HID overlay");

constexpr int BM = 256, BK = 64, HALF = 128, HTB = HALF * BK * 2, STAGE_BYTES = 8 * HTB;
DI int lds_byte(int r, int c) { const int st = (r >> 4) * 2 + (c >> 5), rr = r & 15, cc = c & 31, ob = rr * 64 + cc * 2; return st * 1024 + (ob ^ (((ob >> 9) & 1) << 5)); }
DI void stage_rc(int b, int& R, int& C) { const int st = b / 1024, sb = b % 1024, swz = sb ^ (((sb >> 9) & 1) << 5); R = (st >> 1) * 16 + swz / 64; C = (st & 1) * 32 + (swz % 64) / 2; }
struct Unit { int pa, pb, pm, pn, aux; };
struct GridSched {
    int nM, nN, nwg, G, c, a0, b0;
    DI void init(int nM_, int nN_, int G_, int c_, int a0_, int b0_) { nM = nM_; nN = nN_; nwg = nM * nN; G = G_; c = c_; a0 = a0_; b0 = b0_; }
    DI bool next(int i, Unit& u) const {
        const long L = (long)i * G + c; if (L >= nwg) return false;
        int wgid = (int)L; { const int q = nwg / 8, r = nwg % 8, xcd = wgid % 8, off = wgid / 8; wgid = (xcd < r ? xcd * (q + 1) : r * (q + 1) + (xcd - r) * q) + off; }
        const int nig = 8 * nN, gid = wgid / nig, fm = gid * 8, gsz = (nM - fm) < 8 ? (nM - fm) : 8;
        u.pm = fm + ((wgid % nig) % gsz); u.pn = (wgid % nig) / gsz; u.pa = a0 + u.pm; u.pb = b0 + u.pn; u.aux = 0; return true;
    }
};
struct BranchSched {
    int G, c;
    DI bool next(int i, Unit& u) const {
        const int T = (i / 3) * G + c; if (T >= NTM * 4) return false;
        const int n = i % 3; u.pm = T >> 2; u.pn = T & 3; u.pa = n * NTM + u.pm; u.pb = n * 4 + u.pn; u.aux = n; return true;
    }
};

template <class Epi, class Sched>
DI void gemm_phase(const int tid, LAS unsigned char* lds, const bf16_t* gA, const bf16_t* gB, const int K, const Sched& S, const Epi& E) {
    const int wid = __builtin_amdgcn_readfirstlane(tid >> 6), lane = tid & 63, wr = wid >> 2, wc = wid & 3, fr = lane & 15, fq = lane >> 4;
    const int nt = K / BK;
    unsigned voff[2];
#pragma unroll
    for (int i = 0; i < 2; ++i) { int R, C; stage_rc(tid * 16 + i * 8192, R, C); voff[i] = (unsigned)(R * K + C) * 2u; }
    const size_t kstep = (size_t)(BK * 2);
    const size_t hstep = (size_t)HALF * K * 2;
    const size_t tstep = 2 * hstep;
    const unsigned ldsw = (unsigned)wid * 1024u;
    const int aoff = lds_byte(wr * 64 + fr, fq * 8), boff = lds_byte(wc * 32 + fr, fq * 8);
#define PG8_SA(b, h) (((b) * 2 + (h)) * HTB)
#define PG8_SB(b, h) ((4 + (b) * 2 + (h)) * HTB)
#define PG8_STAGE(bufoff, gbase) do { _Pragma("unroll") for (int _i = 0; _i < 2; ++_i) \
        __builtin_amdgcn_global_load_lds((const unsigned*)((const char*)(gbase) + voff[_i]), (LAS unsigned*)(lds + (bufoff) + ldsw + _i * 8192), 16, 0, 0); } while (0)
#define PG8_LDA(dst, b, h) do { _Pragma("unroll") for (int m = 0; m < 4; ++m) _Pragma("unroll") for (int k = 0; k < 2; ++k) dst[m][k] = *(const LAS bf16x8*)(lds + PG8_SA(b, h) + aoff + m * 2048 + k * 1024); } while (0)
#define PG8_LDB(dst, b, h) do { _Pragma("unroll") for (int n = 0; n < 2; ++n) _Pragma("unroll") for (int k = 0; k < 2; ++k) dst[n][k] = *(const LAS bf16x8*)(lds + PG8_SB(b, h) + boff + n * 2048 + k * 1024); } while (0)
#define PG8_MMA(ai, bj, At, Bt) do { __builtin_amdgcn_s_setprio(1); _Pragma("unroll") for (int m = 0; m < 4; ++m) _Pragma("unroll") for (int n = 0; n < 2; ++n) _Pragma("unroll") for (int k = 0; k < 2; ++k) \
        acc[ai][bj][m][n] = __builtin_amdgcn_mfma_f32_16x16x32_bf16(Bt[n][k], At[m][k], acc[ai][bj][m][n], 0, 0, 0); __builtin_amdgcn_s_setprio(0); } while (0)
#define PG8_WAIT_V(n) asm volatile("s_waitcnt vmcnt(" #n ")" ::: "memory")
#define PG8_WAIT_L(n) asm volatile("s_waitcnt lgkmcnt(" #n ")" ::: "memory")
#define PG8_BAR __builtin_amdgcn_s_barrier()
#define PG8_SCHED __builtin_amdgcn_sched_barrier(0)
    Unit cur, nxt; int ui = 0;
    if (!S.next(0, cur)) return;
    f32x4 acc[2][2][4][2];
#pragma unroll
    for (int a = 0; a < 2; ++a)
#pragma unroll
        for (int b = 0; b < 2; ++b)
#pragma unroll
            for (int m = 0; m < 4; ++m)
#pragma unroll
                for (int n = 0; n < 2; ++n) acc[a][b][m][n] = (f32x4){0.f, 0.f, 0.f, 0.f};
    bf16x8 At[4][2], B0[2][2], B1[2][2];
    const char* cA = (const char*)gA + (size_t)cur.pa * tstep; const char* cB = (const char*)gB + (size_t)cur.pb * tstep;
    PG8_STAGE(PG8_SB(0, 0), cB); PG8_STAGE(PG8_SB(0, 1), cB + hstep); PG8_STAGE(PG8_SA(0, 0), cA); PG8_STAGE(PG8_SA(0, 1), cA + hstep);
    if (wr == 1) PG8_BAR;
    PG8_WAIT_V(2); PG8_BAR;
    PG8_STAGE(PG8_SB(1, 0), cB + kstep); PG8_STAGE(PG8_SA(1, 0), cA + kstep); PG8_STAGE(PG8_SB(1, 1), cB + hstep + kstep);
    PG8_WAIT_V(6); PG8_BAR;
    for (;;) {
        const bool has_next = S.next(ui + 1, nxt);
        const char* nA = has_next ? (const char*)gA + (size_t)nxt.pa * tstep : cA; const char* nB = has_next ? (const char*)gB + (size_t)nxt.pb * tstep : cB;
        for (int t = 0; t < nt; t += 2) {
            const bool last = (t == nt - 2);
            const char* a1 = cA + (size_t)(t + 1) * kstep;
            const char* a2 = last ? nA : cA + (size_t)(t + 2) * kstep; const char* b2 = last ? nB : cB + (size_t)(t + 2) * kstep;
            const char* a3 = a2 + kstep; const char* b3 = b2 + kstep;
            PG8_LDB(B0, 0, 0); PG8_LDB(B1, 0, 1); PG8_SCHED; PG8_LDA(At, 0, 0); PG8_STAGE(PG8_SA(1, 1), a1 + hstep);
            PG8_WAIT_V(8); PG8_WAIT_L(0); PG8_BAR; PG8_MMA(0, 0, At, B0); PG8_MMA(0, 1, At, B1); PG8_BAR; PG8_SCHED;
            PG8_LDA(At, 0, 1); PG8_STAGE(PG8_SB(0, 0), b2); PG8_STAGE(PG8_SB(0, 1), b2 + hstep); PG8_STAGE(PG8_SA(0, 0), a2);
            PG8_WAIT_V(8); PG8_WAIT_L(0); PG8_BAR; PG8_MMA(1, 0, At, B0); PG8_MMA(1, 1, At, B1); PG8_BAR; PG8_SCHED;
            PG8_LDB(B0, 1, 0); PG8_LDB(B1, 1, 1); PG8_SCHED; PG8_LDA(At, 1, 0); PG8_STAGE(PG8_SA(0, 1), a2 + hstep);
            PG8_WAIT_V(8); PG8_WAIT_L(0); PG8_BAR; PG8_MMA(0, 0, At, B0); PG8_MMA(0, 1, At, B1); PG8_BAR; PG8_SCHED;
            PG8_LDA(At, 1, 1); PG8_STAGE(PG8_SB(1, 0), b3); PG8_STAGE(PG8_SB(1, 1), b3 + hstep); PG8_STAGE(PG8_SA(1, 0), a3);
            PG8_WAIT_V(8); PG8_WAIT_L(0); PG8_BAR; PG8_MMA(1, 0, At, B0); PG8_MMA(1, 1, At, B1); PG8_BAR; PG8_SCHED;
        }
        if (wr == 0) PG8_BAR;
        E(acc, cur, wr, wc, fr, fq);
        if (!has_next) break;
#pragma unroll
        for (int a = 0; a < 2; ++a)
#pragma unroll
            for (int b = 0; b < 2; ++b)
#pragma unroll
                for (int m = 0; m < 4; ++m)
#pragma unroll
                    for (int n = 0; n < 2; ++n) acc[a][b][m][n] = (f32x4){0.f, 0.f, 0.f, 0.f};
        cur = nxt; cA = nA; cB = nB; ++ui;
        if (wr == 1) PG8_BAR;
    }
    PG8_WAIT_V(0);
    PG8_BAR;
#undef PG8_SA
#undef PG8_SB
#undef PG8_STAGE
#undef PG8_LDA
#undef PG8_LDB
#undef PG8_MMA
#undef PG8_WAIT_V
#undef PG8_WAIT_L
#undef PG8_BAR
#undef PG8_SCHED
}
#define EPI_LOOP(BODY) _Pragma("unroll") for (int ai = 0; ai < 2; ++ai) _Pragma("unroll") for (int m = 0; m < 4; ++m) { const int row = u.pm * 256 + ai * 128 + wr * 64 + m * 16 + fr; \
    _Pragma("unroll") for (int bj = 0; bj < 2; ++bj) _Pragma("unroll") for (int n = 0; n < 2; ++n) { const int col = bj * 128 + wc * 32 + n * 16 + 4 * fq; const f32x4 v = acc[ai][bj][m][n]; BODY } }
DI void st_bf4(bf16_t* p, f32x4 v) { u32x2 w; w.x = pk2(v[0], v[1]); w.y = pk2(v[2], v[3]); *(u32x2*)p = w; }

struct EpiPlain { bf16_t* O; int ldc;
    DI void operator()(const f32x4 (&acc)[2][2][4][2], const Unit& u, int wr, int wc, int fr, int fq) const { EPI_LOOP( st_bf4(O + (size_t)row * ldc + u.pn * 256 + col, v); ) } };
struct EpiMem { float* pk; float* pv; bf16_t* mkb;
    DI void operator()(const f32x4 (&acc)[2][2][4][2], const Unit& u, int wr, int wc, int fr, int fq) const {
        const bool isk = u.pn < 4; float* dst = isk ? pk : pv; const int c0 = (u.pn & 3) * 256;
        EPI_LOOP( *(f32x4*)(dst + (size_t)row * 1024 + c0 + col) = v; if (isk) st_bf4(mkb + (size_t)row * 1024 + c0 + col, v); ) } };
struct EpiIn { bf16_t *zxr, *zya, *zqs, *zkv, *zxc, *gt; const float* bg; float *pwk, *pwv, *swk, *swv;
    DI void operator()(const f32x4 (&acc)[2][2][4][2], const Unit& u, int wr, int wc, int fr, int fq) const {
        const int pn = u.pn; bf16_t* base; int ldc = 1024, c0, mode; float sc = 1.f;
        if (pn < 4) { base = zxr; c0 = pn * 256; mode = 0; }
        else if (pn < 8) { base = zya; c0 = (pn - 4) * 256; mode = 1; }
        else if (pn < 12) { base = zqs; c0 = (pn - 8) * 256; mode = 2; sc = 0.125f * LOG2E; }
        else if (pn < 14) { base = zkv; ldc = 512; c0 = (pn - 12) * 256; mode = 4; }
        else if (pn < 18) { base = zxc; c0 = (pn - 14) * 256; mode = 2; sc = 0.0625f * LOG2E; }
        else { base = gt; ldc = 3072; c0 = (pn - 18) * 256; mode = 3; }
        float* pw = (pn == 12) ? pwk : pwv; float* sw = (pn == 12) ? swk : swv;
        EPI_LOOP(
            f32x4 o = v;
            if (mode == 1) { o[0] = gelu_tanh(v[0]); o[1] = gelu_tanh(v[1]); o[2] = gelu_tanh(v[2]); o[3] = gelu_tanh(v[3]); }
            else if (mode == 2) { o = v * sc; }
            else if (mode == 3) { const f32x4 bb = *(const f32x4*)(bg + c0 + col); o[0] = sigmoidf_(v[0] + bb[0]); o[1] = sigmoidf_(v[1] + bb[1]); o[2] = sigmoidf_(v[2] + bb[2]); o[3] = sigmoidf_(v[3] + bb[3]); }
            else if (mode == 4) {
                if (row < MPR) { const int t = row & (SEQ - 1); if (t >= SEQ - 128) *(f32x4*)(pw + ((size_t)((row >> 11) * 128 + (t - (SEQ - 128))) * 256 + col)) = v; }
                else if (row < MREAL) { *(f32x4*)(sw + ((size_t)((row - MPR) * 128 + 127) * 256 + col)) = v; }
            }
            st_bf4(base + (size_t)row * ldc + c0 + col, o); ) } };
struct EpiBranch { const bf16_t* gt; bf16_t* mg;
    DI void operator()(const f32x4 (&acc)[2][2][4][2], const Unit& u, int wr, int wc, int fr, int fq) const {
        const int nb = u.aux, c0 = u.pn * 256;
        EPI_LOOP(
            const u32x2 g = *(const u32x2*)(gt + (size_t)row * 3072 + nb * 1024 + c0 + col);
            f32x4 o; o[0] = bflo(g.x) * v[0]; o[1] = bfhi(g.x) * v[1]; o[2] = bflo(g.y) * v[2]; o[3] = bfhi(g.y) * v[3];
            bf16_t* p = mg + (size_t)row * 1024 + c0 + col;
            if (nb > 0) { const u32x2 q = *(const u32x2*)p; o[0] += bflo(q.x); o[1] += bfhi(q.x); o[2] += bflo(q.y); o[3] += bfhi(q.y); }
            st_bf4(p, o); ) } };
struct EpiRes { const float* resP; const float* resS; float* Y;
    DI void operator()(const f32x4 (&acc)[2][2][4][2], const Unit& u, int wr, int wc, int fr, int fq) const {
        const int c0 = u.pn * 256;
        EPI_LOOP(
            if (row < MREAL) { const float* rp = (row < MPR) ? resP + (size_t)row * 1024 : resS + (size_t)(row - MPR) * 1024;
                const f32x4 r = *(const f32x4*)(rp + c0 + col); *(f32x4*)(Y + (size_t)row * 1024 + c0 + col) = r * ALPHA + v; } ) } };
struct EpiGLU { bf16_t* hid;
    DI void operator()(const f32x4 (&acc)[2][2][4][2], const Unit& u, int wr, int wc, int fr, int fq) const {
#pragma unroll
        for (int ai = 0; ai < 2; ++ai)
#pragma unroll
            for (int m = 0; m < 4; ++m) { const int row = u.pm * 256 + ai * 128 + wr * 64 + m * 16 + fr;
#pragma unroll
                for (int n = 0; n < 2; ++n) { const int col = u.pn * 128 + wc * 32 + n * 16 + 4 * fq; const f32x4 g = acc[ai][0][m][n], up = acc[ai][1][m][n]; f32x4 o;
                    o[0] = g[0] * sigmoidf_(g[0]) * up[0]; o[1] = g[1] * sigmoidf_(g[1]) * up[1]; o[2] = g[2] * sigmoidf_(g[2]) * up[2]; o[3] = g[3] * sigmoidf_(g[3]) * up[3];
                    st_bf4(hid + (size_t)row * DFF + col, o); } } } };

DI float wave_sum(float v) {
#pragma unroll
    for (int o = 1; o < 64; o <<= 1) v += __shfl_xor(v, o);
    return v;
}
DI float wave_max(float v) {
#pragma unroll
    for (int o = 1; o < 64; o <<= 1) v = fmaxf(v, __shfl_xor(v, o));
    return v;
}
DI void transpose_item(const float* W, int ldw, int src_col0, int k0, bf16_t* WT, int ldk, int dst_row0, float* scr, int lane) {
#pragma unroll 8
    for (int i = 0; i < 32; ++i) { const int kk = 2 * i + (lane >> 5); scr[kk * 33 + (lane & 31)] = W[(size_t)(k0 + kk) * ldw + src_col0 + (lane & 31)]; }
    asm volatile("s_waitcnt lgkmcnt(0)" ::: "memory");
    const int c = lane & 7;
#pragma unroll
    for (int j = 0; j < 4; ++j) { const int n = (lane >> 3) + 8 * j; const float* s = scr + (8 * c) * 33 + n;
        u32x4 o; o.x = pk2(s[0 * 33], s[1 * 33]); o.y = pk2(s[2 * 33], s[3 * 33]); o.z = pk2(s[4 * 33], s[5 * 33]); o.w = pk2(s[6 * 33], s[7 * 33]);
        *(u32x4*)(WT + (size_t)(dst_row0 + n) * ldk + k0 + 8 * c) = o; }
    asm volatile("s_waitcnt lgkmcnt(0)" ::: "memory");
}

struct Args { const float* in[28]; float* out; unsigned char* ws; int ph_lo, ph_hi, coop, pad; };
enum { I_XP = 0, I_XS, I_SCONV, I_SH, I_CWK, I_CWV, I_CMK, I_CMV, I_MEMP, I_WMKV, I_WIN, I_BG, I_CW, I_CB, I_WA, I_BA, I_WX, I_BX, I_LAM, I_SINK, I_WBR, I_WOUT, I_L1G, I_L1B, I_WGU, I_WDN, I_L2G, I_L2B };

DI void prologue(const Args& a, unsigned char* lds, int gw, int NGW, int lane, int wave) {
    unsigned char* ws = a.ws;
    float* scr = (float*)(lds + wave * 16384);
    constexpr int N_IN = 16 * 240, N_MK = 16 * 64, N_BR = 3 * 16 * 32, N_OUT = 16 * 32, N_GU = 16 * 176, N_DN = 44 * 32, N_L = N_IN + N_MK + N_BR + N_OUT + N_GU + N_DN;
    for (int it = gw; it < 2 * N_L; it += NGW) {
        const int l = it / N_L; int r = it % N_L;
        if (r < N_IN) { const int kb = r / 240, nb = r % 240; transpose_item(a.in[I_WIN] + (size_t)l * DM * INC, INC, 32 * nb, 64 * kb, (bf16_t*)(ws + WS_WIN) + (size_t)l * INC * DM, DM, 32 * nb, scr, lane); continue; } r -= N_IN;
        if (r < N_MK) { const int kb = r / 64, nb = r % 64; transpose_item(a.in[I_WMKV] + (size_t)l * DM * 2048, 2048, 32 * nb, 64 * kb, (bf16_t*)(ws + WS_WMKV) + (size_t)l * 2048 * DM, DM, 32 * nb, scr, lane); continue; } r -= N_MK;
        if (r < N_BR) { const int n = r / 512, rr = r % 512, kb = rr / 32, nb = rr % 32; transpose_item(a.in[I_WBR] + (size_t)(l * 3 + n) * DM * DM, DM, 32 * nb, 64 * kb, (bf16_t*)(ws + WS_WBR) + (size_t)l * 3072 * DM, DM, n * 1024 + 32 * nb, scr, lane); continue; } r -= N_BR;
        if (r < N_OUT) { const int kb = r / 32, nb = r % 32; transpose_item(a.in[I_WOUT] + (size_t)l * DM * DM, DM, 32 * nb, 64 * kb, (bf16_t*)(ws + WS_WOUT) + (size_t)l * DM * DM, DM, 32 * nb, scr, lane); continue; } r -= N_OUT;
        if (r < N_GU) { const int kb = r / 176, nb = r % 176, dr = 32 * nb, pn = dr >> 8, half = (dr >> 7) & 1, cc = dr & 127;
            transpose_item(a.in[I_WGU] + (size_t)l * DM * 2 * DFF, 2 * DFF, half * DFF + 128 * pn + cc, 64 * kb, (bf16_t*)(ws + WS_WGU) + (size_t)l * 2 * DFF * DM, DM, dr, scr, lane); continue; } r -= N_GU;
        { const int kb = r / 32, nb = r % 32; transpose_item(a.in[I_WDN] + (size_t)l * DFF * DM, DM, 32 * nb, 64 * kb, (bf16_t*)(ws + WS_WDN) + (size_t)l * DM * DFF, DFF, 32 * nb, scr, lane); }
    }
    const int gt_ = gw * 64 + lane, GT_ = NGW * 64;
    bf16_t* rb = (bf16_t*)(ws + WS_RB);
    for (int i = gt_; i < MT * 128; i += GT_) { const int row = i >> 7, c8 = (i & 127) * 8; u32x4 o = {0u, 0u, 0u, 0u};
        if (row < MREAL) { const float* s = (row < MPR ? a.in[I_XP] + (size_t)row * 1024 : a.in[I_XS] + (size_t)(row - MPR) * 1024) + c8; const f32x4 v0 = *(const f32x4*)s, v1 = *(const f32x4*)(s + 4);
            o.x = pk2(v0[0], v0[1]); o.y = pk2(v0[2], v0[3]); o.z = pk2(v1[0], v1[1]); o.w = pk2(v1[2], v1[3]); }
        *(u32x4*)(rb + (size_t)row * 1024 + c8) = o; }
    bf16_t* mpb = (bf16_t*)(ws + WS_MPB);
    for (int i = gt_; i < 4096 * 128; i += GT_) { const float* s = a.in[I_MEMP] + (size_t)i * 8; const f32x4 v0 = *(const f32x4*)s, v1 = *(const f32x4*)(s + 4); u32x4 o;
        o.x = pk2(v0[0], v0[1]); o.y = pk2(v0[2], v0[3]); o.z = pk2(v1[0], v1[1]); o.w = pk2(v1[2], v1[3]); *(u32x4*)(mpb + (size_t)i * 8) = o; }
}

DI void ln_phase(const float* Y, const float* g, const float* bt, float* outF, bf16_t* outB, int gw, int NGW, int lane) {
    f32x4 gv[4], bv[4];
#pragma unroll
    for (int j = 0; j < 4; ++j) { gv[j] = *(const f32x4*)(g + 4 * lane + 256 * j); bv[j] = *(const f32x4*)(bt + 4 * lane + 256 * j); }
    for (int row = gw; row < MREAL; row += NGW) {
        const float* y = Y + (size_t)row * 1024 + 4 * lane; f32x4 v[4]; float s = 0.f;
#pragma unroll
        for (int j = 0; j < 4; ++j) { v[j] = *(const f32x4*)(y + 256 * j); s += (v[j][0] + v[j][1]) + (v[j][2] + v[j][3]); }
        const float mean = wave_sum(s) * (1.f / 1024.f); float s2 = 0.f;
#pragma unroll
        for (int j = 0; j < 4; ++j) { v[j] = v[j] - mean; s2 += (v[j][0] * v[j][0] + v[j][1] * v[j][1]) + (v[j][2] * v[j][2] + v[j][3] * v[j][3]); }
        const float rstd = 1.f / sqrtf(wave_sum(s2) * (1.f / 1024.f) + LN_EPS);
#pragma unroll
        for (int j = 0; j < 4; ++j) { const f32x4 o = v[j] * rstd * gv[j] + bv[j]; *(f32x4*)(outF + (size_t)row * 1024 + 4 * lane + 256 * j) = o; st_bf4(outB + (size_t)row * 1024 + 4 * lane + 256 * j, o); }
    }
}

struct LruP { const float *cw, *cb, *wa, *ba, *wx, *bx, *lam; };
DI void lru_gate(float rpre, float ipre, float xc, float nsp, float& a, float& uu) {
    const float r = sigmoidf_(rpre), ig = sigmoidf_(ipre);
    const float la = nsp * r;
    a = __expf(la); uu = sqrtf(fmaxf(-expm1f(2.f * la), 0.f)) * (ig * xc);
}
DI void lru_item(const int tid, unsigned char* lds, int b, int blk, const LruP& P, const bf16_t* zxr, bf16_t* zya, float* pconv_l, float* ph_l) {
    const int lane = tid & 63, w = tid >> 6, fr = lane & 15, fq = lane >> 4, c = blk * 64 + lane;
    bf16_t* xcs = (bf16_t*)lds + w * 16 * 72;
    float* rp = (float*)(lds + 18432) + w * 16 * 68;
    float* ip = (float*)(lds + 18432 + 34816) + w * 16 * 68;
    float* tot = (float*)(lds + 18432 + 2 * 34816);
    const float cw0 = P.cw[c], cw1 = P.cw[1024 + c], cw2 = P.cw[2048 + c], cw3 = P.cw[3072 + c], cb = P.cb[c], ba = P.ba[c], bx = P.bx[c];
    const float nsp = -8.f * log1pf(__expf(-P.lam[c]));
    bf16x8 Ba[4][2], Bx[4][2];
#pragma unroll
    for (int nt = 0; nt < 4; ++nt)
#pragma unroll
        for (int ks = 0; ks < 2; ++ks)
#pragma unroll
            for (int e = 0; e < 8; ++e) { const int i = 32 * ks + 8 * fq + e, j = 16 * nt + fr;
                Ba[nt][ks][e] = (short)f2bf(P.wa[((size_t)blk * 64 + i) * 64 + j]); Bx[nt][ks][e] = (short)f2bf(P.wx[((size_t)blk * 64 + i) * 64 + j]); }
    float carry = 0.f; int par = 0;
    for (int chunk = 0; chunk < 16; ++chunk) {
        const int t0 = chunk * 128 + 16 * w; const size_t rowbase = (size_t)b * SEQ + t0;
        float x[19], gy[16];
#pragma unroll
        for (int k = 0; k < 19; ++k) x[k] = (t0 + k - 3 >= 0) ? bf2f(zxr[(rowbase + k - 3) * 1024 + c]) : 0.f;
#pragma unroll
        for (int t = 0; t < 16; ++t) gy[t] = bf2f(zya[(rowbase + t) * 1024 + c]);
        float xc[16];
#pragma unroll
        for (int t = 0; t < 16; ++t) { xc[t] = cb + cw0 * x[t] + cw1 * x[t + 1] + cw2 * x[t + 2] + cw3 * x[t + 3]; xcs[t * 72 + lane] = f2bf(xc[t]); }
        const bf16x8 A0 = *(const bf16x8*)&xcs[fr * 72 + 8 * fq], A1 = *(const bf16x8*)&xcs[fr * 72 + 32 + 8 * fq];
#pragma unroll
        for (int nt = 0; nt < 4; ++nt) {
            f32x4 r = __builtin_amdgcn_mfma_f32_16x16x32_bf16(A0, Ba[nt][0], (f32x4){0.f, 0.f, 0.f, 0.f}, 0, 0, 0); r = __builtin_amdgcn_mfma_f32_16x16x32_bf16(A1, Ba[nt][1], r, 0, 0, 0);
            f32x4 q = __builtin_amdgcn_mfma_f32_16x16x32_bf16(A0, Bx[nt][0], (f32x4){0.f, 0.f, 0.f, 0.f}, 0, 0, 0); q = __builtin_amdgcn_mfma_f32_16x16x32_bf16(A1, Bx[nt][1], q, 0, 0, 0);
#pragma unroll
            for (int j = 0; j < 4; ++j) { rp[(4 * fq + j) * 68 + 16 * nt + fr] = r[j]; ip[(4 * fq + j) * 68 + 16 * nt + fr] = q[j]; }
        }
        float Hs[16], Ps[16]; float Hc = 0.f, Pc = 1.f;
#pragma unroll
        for (int t = 0; t < 16; ++t) { float av, uv; lru_gate(rp[t * 68 + lane] + ba, ip[t * 68 + lane] + bx, xc[t], nsp, av, uv); Hc = av * Hc + uv; Pc = av * Pc; Hs[t] = Hc; Ps[t] = Pc; }
        tot[((par * 8 + w) * 64 + lane) * 2 + 0] = Pc; tot[((par * 8 + w) * 64 + lane) * 2 + 1] = Hc;
        __syncthreads();
        float h = carry, hin = 0.f;
#pragma unroll
        for (int w2 = 0; w2 < 8; ++w2) { const float p = tot[((par * 8 + w2) * 64 + lane) * 2 + 0], hh = tot[((par * 8 + w2) * 64 + lane) * 2 + 1]; if (w2 == w) hin = h; h = p * h + hh; }
        carry = h; par ^= 1;
#pragma unroll
        for (int t = 0; t < 16; ++t) zya[(rowbase + t) * 1024 + c] = f2bf((Hs[t] + Ps[t] * hin) * gy[t]);
        if (chunk == 15 && w == 7) {
#pragma unroll
            for (int k = 0; k < 3; ++k) pconv_l[((size_t)b * 3 + k) * 1024 + c] = x[16 + k];
        }
    }
    if (w == 0) ph_l[(size_t)b * 1024 + c] = carry;
    __syncthreads();
}
DI void lru_sample(int b, int blk, int lane, const LruP& P, const bf16_t* zxr, bf16_t* zya, const float* sconv_l, const float* sh_l, float* oconv_l, float* oh_l) {
    const int c = blk * 64 + lane; const size_t row = (size_t)MPR + b;
    const float xn = bf2f(zxr[row * 1024 + c]);
    const float s0 = sconv_l[((size_t)b * 3 + 0) * 1024 + c], s1 = sconv_l[((size_t)b * 3 + 1) * 1024 + c], s2 = sconv_l[((size_t)b * 3 + 2) * 1024 + c];
    const float xc = P.cb[c] + P.cw[c] * s0 + P.cw[1024 + c] * s1 + P.cw[2048 + c] * s2 + P.cw[3072 + c] * xn;
    float rpre = P.ba[c], ipre = P.bx[c];
#pragma unroll 8
    for (int i = 0; i < 64; ++i) { const float xi = __shfl(xc, i); rpre += xi * P.wa[((size_t)blk * 64 + i) * 64 + lane]; ipre += xi * P.wx[((size_t)blk * 64 + i) * 64 + lane]; }
    const float nsp = -8.f * log1pf(__expf(-P.lam[c]));
    float av, uv; lru_gate(rpre, ipre, xc, nsp, av, uv);
    const float h = av * sh_l[(size_t)b * 1024 + c] + uv;
    zya[row * 1024 + c] = f2bf(h * bf2f(zya[row * 1024 + c]));
    oconv_l[((size_t)b * 3 + 0) * 1024 + c] = s1; oconv_l[((size_t)b * 3 + 1) * 1024 + c] = s2; oconv_l[((size_t)b * 3 + 2) * 1024 + c] = xn;
    oh_l[(size_t)b * 1024 + c] = h;
}

DI void swa_item(const int tid, unsigned char* lds, int b, int kvh, int qb, const bf16_t* zkv, const bf16_t* vt, bf16_t* zqs, const float* sinks_l) {
    const int lane = tid & 63, w = tid >> 6, fr = lane & 15, fq = lane >> 4;
    bf16_t* Ks = (bf16_t*)lds;
    bf16_t* Vs = (bf16_t*)(lds + 36864);
#pragma unroll
    for (int i = 0; i < 4; ++i) { const int ch = tid + 512 * i;
        { const int r = ch >> 3, c8 = ch & 7; const int tok = (qb == 0 && r < 128) ? r : 128 * (qb - 1) + r;
          *(u32x4*)&Ks[r * 72 + c8 * 8] = *(const u32x4*)&zkv[((size_t)b * SEQ + tok) * 512 + kvh * 64 + c8 * 8]; }
        { const int d = ch >> 5, rem = ch & 31, half = rem >> 4, c16 = rem & 15; const int tokbase = half ? 128 * qb : (qb == 0 ? 0 : 128 * (qb - 1));
          *(u32x4*)&Vs[d * 272 + half * 128 + c16 * 8] = *(const u32x4*)&vt[(size_t)(kvh * 64 + d) * MT + (size_t)b * SEQ + tokbase + c16 * 8]; }
    }
    __syncthreads();
    const int head = kvh * 4 + (w >> 1), qh = w & 1; const float sink = sinks_l[head] * LOG2E;
    for (int p = 0; p < 2; ++p) {
        const int q0 = 64 * qh + 32 * p, kt0 = q0 >> 4; const size_t rowq = (size_t)b * SEQ + 128 * qb + q0;
        bf16x8 Qf[2][2];
#pragma unroll
        for (int qt = 0; qt < 2; ++qt)
#pragma unroll
            for (int ks = 0; ks < 2; ++ks) Qf[qt][ks] = *(const bf16x8*)&zqs[(rowq + 16 * qt + fr) * 1024 + head * 64 + 32 * ks + 8 * fq];
        f32x4 S[10][2];
#pragma unroll
        for (int i = 0; i < 10; ++i) {
            const bf16x8 K0 = *(const bf16x8*)&Ks[(16 * (kt0 + i) + fr) * 72 + 8 * fq], K1 = *(const bf16x8*)&Ks[(16 * (kt0 + i) + fr) * 72 + 32 + 8 * fq];
#pragma unroll
            for (int qt = 0; qt < 2; ++qt) { S[i][qt] = __builtin_amdgcn_mfma_f32_16x16x32_bf16(K0, Qf[qt][0], (f32x4){0.f, 0.f, 0.f, 0.f}, 0, 0, 0); S[i][qt] = __builtin_amdgcn_mfma_f32_16x16x32_bf16(K1, Qf[qt][1], S[i][qt], 0, 0, 0); }
        }
        float den[2];
#pragma unroll
        for (int qt = 0; qt < 2; ++qt) {
            const int jq = q0 + 16 * qt + fr; float mx = -1e30f;
#pragma unroll
            for (int i = 0; i < 10; ++i)
#pragma unroll
                for (int j = 0; j < 4; ++j) { const int m = 16 * (kt0 + i) + 4 * fq + j; const bool valid = (m > jq) && (m <= jq + 128) && (qb > 0 || m >= 128);
                    const float s = valid ? S[i][qt][j] : -1e30f; S[i][qt][j] = s; mx = fmaxf(mx, s); }
            mx = fmaxf(mx, __shfl_xor(mx, 16)); mx = fmaxf(mx, __shfl_xor(mx, 32)); mx = fmaxf(mx, sink);
            float sum = 0.f;
#pragma unroll
            for (int i = 0; i < 10; ++i)
#pragma unroll
                for (int j = 0; j < 4; ++j) { const float e = fexp2(S[i][qt][j] - mx); S[i][qt][j] = e; sum += e; }
            sum += __shfl_xor(sum, 16); sum += __shfl_xor(sum, 32);
            den[qt] = sum + fexp2(sink - mx);
        }
        f32x4 O[4][2];
#pragma unroll
        for (int dt = 0; dt < 4; ++dt) { O[dt][0] = (f32x4){0.f, 0.f, 0.f, 0.f}; O[dt][1] = (f32x4){0.f, 0.f, 0.f, 0.f}; }
#pragma unroll
        for (int ii = 0; ii < 5; ++ii) {
            bf16x8 Pf[2];
#pragma unroll
            for (int qt = 0; qt < 2; ++qt) { u32x4 pw; pw.x = pk2(S[2 * ii][qt][0], S[2 * ii][qt][1]); pw.y = pk2(S[2 * ii][qt][2], S[2 * ii][qt][3]); pw.z = pk2(S[2 * ii + 1][qt][0], S[2 * ii + 1][qt][1]); pw.w = pk2(S[2 * ii + 1][qt][2], S[2 * ii + 1][qt][3]); Pf[qt] = __builtin_bit_cast(bf16x8, pw); }
#pragma unroll
            for (int dt = 0; dt < 4; ++dt) {
                const s16x4 lo = *(const s16x4*)&Vs[(16 * dt + fr) * 272 + 16 * (kt0 + 2 * ii) + 4 * fq], hi = *(const s16x4*)&Vs[(16 * dt + fr) * 272 + 16 * (kt0 + 2 * ii) + 16 + 4 * fq];
                const bf16x8 Vf = {lo[0], lo[1], lo[2], lo[3], hi[0], hi[1], hi[2], hi[3]};
#pragma unroll
                for (int qt = 0; qt < 2; ++qt) O[dt][qt] = __builtin_amdgcn_mfma_f32_16x16x32_bf16(Vf, Pf[qt], O[dt][qt], 0, 0, 0);
            }
        }
#pragma unroll
        for (int qt = 0; qt < 2; ++qt) { const float inv = 1.f / den[qt];
#pragma unroll
            for (int dt = 0; dt < 4; ++dt) st_bf4(&zqs[(rowq + 16 * qt + fr) * 1024 + head * 64 + 16 * dt + 4 * fq], O[dt][qt] * inv); }
    }
    __syncthreads();
}
DI void swa_sample(int b, int head, int lane, const float* cwk_l, const float* cwv_l, const float* newk_l, const float* newv_l, bf16_t* zqs, const float* sinks_l) {
    const int kvh = head >> 2; const size_t row = (size_t)MPR + b;
    const float qv = bf2f(zqs[row * 1024 + head * 64 + lane]);
    float s[2];
#pragma unroll
    for (int hh = 0; hh < 2; ++hh) { const int j = lane + 64 * hh;
        const float* kp = (j < 127) ? cwk_l + ((size_t)(b * 128 + j + 1) * 4 + kvh) * 64 : newk_l + ((size_t)(b * 128 + 127) * 4 + kvh) * 64;
        float acc = 0.f;
#pragma unroll
        for (int d4 = 0; d4 < 16; ++d4) { const f32x4 kv = *(const f32x4*)(kp + 4 * d4);
            acc += __shfl(qv, 4 * d4) * kv[0] + __shfl(qv, 4 * d4 + 1) * kv[1] + __shfl(qv, 4 * d4 + 2) * kv[2] + __shfl(qv, 4 * d4 + 3) * kv[3]; }
        s[hh] = acc; }
    const float sink = sinks_l[head] * LOG2E;
    const float mx = fmaxf(wave_max(fmaxf(s[0], s[1])), sink);
    const float e0 = fexp2(s[0] - mx), e1 = fexp2(s[1] - mx);
    const float den = wave_sum(e0 + e1) + fexp2(sink - mx);
    float o = 0.f;
#pragma unroll 8
    for (int j = 0; j < 128; ++j) { const float pj = __shfl((j < 64) ? e0 : e1, j & 63);
        const float* vp = (j < 127) ? cwv_l + ((size_t)(b * 128 + j + 1) * 4 + kvh) * 64 : newv_l + ((size_t)(b * 128 + 127) * 4 + kvh) * 64;
        o += pj * vp[lane]; }
    zqs[row * 1024 + head * 64 + lane] = f2bf(o / den);
}

DI void mem_item(const int tid, unsigned char* lds, int b, int h, int q8, const bf16_t* mkb_l, const bf16_t* mvt_l, bf16_t* zxc) {
    const int lane = tid & 63, w = tid >> 6, fr = lane & 15, fq = lane >> 4;
    bf16_t* Km = (bf16_t*)lds;
#pragma unroll
    for (int i = 0; i < 16; ++i) { const int ch = tid + 512 * i, r = ch >> 5, c16 = ch & 31;
        *(u32x4*)&Km[r * 264 + c16 * 8] = *(const u32x4*)&mkb_l[((size_t)b * 256 + r) * 1024 + h * 256 + c16 * 8]; }
    const size_t row = (size_t)b * SEQ + 128 * q8 + 16 * w + fr;
    bf16x8 Qf[8];
#pragma unroll
    for (int ks = 0; ks < 8; ++ks) Qf[ks] = *(const bf16x8*)&zxc[row * 1024 + h * 256 + 32 * ks + 8 * fq];
    __syncthreads();
    f32x4 S[16];
#pragma unroll
    for (int kt = 0; kt < 16; ++kt) { f32x4 acc = {0.f, 0.f, 0.f, 0.f};
#pragma unroll
        for (int ks = 0; ks < 8; ++ks) { const bf16x8 Kf = *(const bf16x8*)&Km[(16 * kt + fr) * 264 + 32 * ks + 8 * fq]; acc = __builtin_amdgcn_mfma_f32_16x16x32_bf16(Kf, Qf[ks], acc, 0, 0, 0); }
        S[kt] = acc; }
    float mx = -1e30f;
#pragma unroll
    for (int kt = 0; kt < 16; ++kt) mx = fmaxf(fmaxf(mx, fmaxf(S[kt][0], S[kt][1])), fmaxf(S[kt][2], S[kt][3]));
    mx = fmaxf(mx, __shfl_xor(mx, 16)); mx = fmaxf(mx, __shfl_xor(mx, 32));
    float sum = 0.f; bf16x8 Pf[8];
#pragma unroll
    for (int ii = 0; ii < 8; ++ii) { f32x4 e0, e1;
#pragma unroll
        for (int j = 0; j < 4; ++j) { e0[j] = fexp2(S[2 * ii][j] - mx); e1[j] = fexp2(S[2 * ii + 1][j] - mx); }
        sum += (e0[0] + e0[1]) + (e0[2] + e0[3]) + (e1[0] + e1[1]) + (e1[2] + e1[3]);
        u32x4 pw; pw.x = pk2(e0[0], e0[1]); pw.y = pk2(e0[2], e0[3]); pw.z = pk2(e1[0], e1[1]); pw.w = pk2(e1[2], e1[3]); Pf[ii] = __builtin_bit_cast(bf16x8, pw); }
    sum += __shfl_xor(sum, 16); sum += __shfl_xor(sum, 32);
    __syncthreads();
    bf16_t* Vm = (bf16_t*)lds;
#pragma unroll
    for (int i = 0; i < 16; ++i) { const int ch = tid + 512 * i, r = ch >> 5, c16 = ch & 31;
        *(u32x4*)&Vm[r * 272 + c16 * 8] = *(const u32x4*)&mvt_l[((size_t)h * 256 + r) * 4096 + (size_t)b * 256 + c16 * 8]; }
    __syncthreads();
    const float inv = 1.f / sum;
#pragma unroll
    for (int dt = 0; dt < 16; ++dt) { f32x4 acc = {0.f, 0.f, 0.f, 0.f};
#pragma unroll
        for (int ii = 0; ii < 8; ++ii) { const s16x4 lo = *(const s16x4*)&Vm[(16 * dt + fr) * 272 + 32 * ii + 4 * fq], hi = *(const s16x4*)&Vm[(16 * dt + fr) * 272 + 32 * ii + 16 + 4 * fq];
            const bf16x8 Vf = {lo[0], lo[1], lo[2], lo[3], hi[0], hi[1], hi[2], hi[3]}; acc = __builtin_amdgcn_mfma_f32_16x16x32_bf16(Vf, Pf[ii], acc, 0, 0, 0); }
        st_bf4(&zxc[row * 1024 + h * 256 + 16 * dt + 4 * fq], acc * inv); }
    __syncthreads();
}
DI void mem_sample(const int tid, unsigned char* lds, int b, int h, const float* cmk_l, const float* cmv_l, bf16_t* zxc) {
    const int lane = tid & 63, w = tid >> 6; const size_t row = (size_t)MPR + b;
    float* sc = (float*)lds;
    float* po = (float*)lds + 256;
    f32x4 q; { const u32x2 qq = *(const u32x2*)&zxc[row * 1024 + h * 256 + 4 * lane]; q[0] = bflo(qq.x); q[1] = bfhi(qq.x); q[2] = bflo(qq.y); q[3] = bfhi(qq.y); }
    const float* kb = cmk_l + (((size_t)b * 256 + 32 * w) * 4 + h) * 256 + 4 * lane;
#pragma unroll 8
    for (int kk = 0; kk < 32; ++kk) { const f32x4 kv = *(const f32x4*)(kb + (size_t)kk * 1024); float d = (q[0] * kv[0] + q[1] * kv[1]) + (q[2] * kv[2] + q[3] * kv[3]); d = wave_sum(d); if (lane == 0) sc[32 * w + kk] = d; }
    __syncthreads();
    const f32x4 sv = *(const f32x4*)&sc[4 * lane];
    const float mx = wave_max(fmaxf(fmaxf(sv[0], sv[1]), fmaxf(sv[2], sv[3])));
    const float sum = wave_sum((fexp2(sv[0] - mx) + fexp2(sv[1] - mx)) + (fexp2(sv[2] - mx) + fexp2(sv[3] - mx)));
    const float inv = 1.f / sum;
    const float* vb = cmv_l + (((size_t)b * 256 + 32 * w) * 4 + h) * 256 + 4 * lane;
    f32x4 o = {0.f, 0.f, 0.f, 0.f};
#pragma unroll 8
    for (int kk = 0; kk < 32; ++kk) { const float p = fexp2(sc[32 * w + kk] - mx) * inv; const f32x4 vv = *(const f32x4*)(vb + (size_t)kk * 1024); o += vv * p; }
    *(f32x4*)&po[w * 256 + 4 * lane] = o;
    __syncthreads();
    if (tid < 256) { float s = 0.f;
#pragma unroll
        for (int ww = 0; ww < 8; ++ww) s += po[ww * 256 + tid];
        zxc[row * 1024 + h * 256 + tid] = f2bf(s); }
    __syncthreads();
}

__global__ void __launch_bounds__(512, 2) fwd_kernel(Args a) {
    extern __shared__ __attribute__((aligned(16))) unsigned char lds[];
    cg::grid_group grid = cg::this_grid();
    LAS unsigned char* ldsl = (LAS unsigned char*)lds;
    int ph = 0;
#define PHASE_BEGIN if (a.coop || (ph >= a.ph_lo && ph < a.ph_hi)) { unsigned char* ws = a.ws; float* out = a.out; int G = gridDim.x, bid = blockIdx.x, l = l0, tid = threadIdx.x; \
        asm volatile("" : "+s"(ws), "+s"(out), "+s"(G), "+s"(bid), "+s"(l), "+v"(tid)); const int lane = tid & 63, wave = tid >> 6; (void)lane; const int gw = bid * 8 + wave, NGW = G * 8; (void)gw; (void)NGW; (void)out; (void)l;
#define PHASE_END } ++ph; if (a.coop) grid.sync();
#define RB_ ((bf16_t*)(ws + WS_RB))
#define RF_ ((float*)(ws + WS_RF))
#define ZYA_ ((bf16_t*)(ws + WS_ZYA))
#define ZQS_ ((bf16_t*)(ws + WS_ZQS))
#define ZXC_ ((bf16_t*)(ws + WS_ZXC))
#define ZXR_ ((bf16_t*)(ws + WS_ZXR))
#define ZKV_ ((bf16_t*)(ws + WS_ZKV))
#define GT_ ((bf16_t*)(ws + WS_GT))
#define MG_ ((bf16_t*)(ws + WS_MG))
#define VT_ ((bf16_t*)(ws + WS_VT))
#define HID_ ((bf16_t*)(ws + WS_ZYA))
#define MPB_ ((bf16_t*)(ws + WS_MPB))
#define Y_ ((float*)(ws + WS_GT))
    { const int l0 = 0;
    PHASE_BEGIN
#ifndef SK_PRO
    prologue(a, lds, gw, NGW, lane, wave);
#endif
    PHASE_END
    }
    for (int l0 = 0; l0 < 2; ++l0) {
        PHASE_BEGIN
        {
            const bf16_t* WIN = (const bf16_t*)(ws + WS_WIN) + (size_t)l * INC * DM;
            {
            EpiIn E{ZXR_, ZYA_, ZQS_, ZKV_, ZXC_, GT_, a.in[I_BG] + (size_t)l * 3072, out + O_PWK + (size_t)l * 16 * 128 * 256, out + O_PWV + (size_t)l * 16 * 128 * 256,
                    out + O_SWK + (size_t)l * 128 * 128 * 256, out + O_SWV + (size_t)l * 128 * 128 * 256};
            GridSched S; S.init(NTM, 30, G, bid, 0, 0);
            gemm_phase(tid, ldsl, RB_, WIN, DM, S, E);
            }
            { EpiPlain ET{VT_, MT}; GridSched S2; S2.init(1, NTM, G, (bid + 30) % G, 13, 0);
            gemm_phase(tid, ldsl, WIN, RB_, DM, S2, ET); }
            if (l == 0) {
                for (int l2 = 0; l2 < 2; ++l2) {
                    const bf16_t* WMK = (const bf16_t*)(ws + WS_WMKV) + (size_t)l2 * 2048 * DM;
                    { EpiMem EM{out + O_PMK + (size_t)l2 * 4096 * 1024, out + O_PMV + (size_t)l2 * 4096 * 1024, (bf16_t*)(ws + WS_MKB) + (size_t)l2 * 4096 * DM};
                    GridSched S3; S3.init(16, 8, G, (bid + 159 + 192 * l2) % G, 0, 0);
                    gemm_phase(tid, ldsl, MPB_, WMK, DM, S3, EM); }
                    { EpiPlain EV{(bf16_t*)(ws + WS_MVT) + (size_t)l2 * 4096 * DM, 4096}; GridSched S4; S4.init(4, 16, G, (bid + 31 + 192 * l2) % G, 4, 0);
                    gemm_phase(tid, ldsl, WMK, MPB_, DM, S4, EV); }
                }
            }
        }
        PHASE_END
        PHASE_BEGIN
        {
            const LruP LP{a.in[I_CW] + (size_t)l * 4096, a.in[I_CB] + (size_t)l * 1024, a.in[I_WA] + (size_t)l * 65536, a.in[I_BA] + (size_t)l * 1024, a.in[I_WX] + (size_t)l * 65536, a.in[I_BX] + (size_t)l * 1024, a.in[I_LAM] + (size_t)l * 1024};
            const float* sinks_l = a.in[I_SINK] + l * 16;
#ifndef SK_SAMPLE
            for (int it = bid; it < 512; it += G) mem_sample(tid, lds, it >> 2, it & 3, a.in[I_CMK] + (size_t)l * 128 * 256 * 1024, a.in[I_CMV] + (size_t)l * 128 * 256 * 1024, ZXC_);
            for (int it = gw; it < 2048; it += NGW) lru_sample(it >> 4, it & 15, lane, LP, ZXR_, ZYA_, a.in[I_SCONV] + (size_t)l * 128 * 3 * 1024, a.in[I_SH] + (size_t)l * 128 * 1024, out + O_SCONV + (size_t)l * 128 * 3 * 1024, out + O_SH + (size_t)l * 128 * 1024);
            for (int it = gw; it < 2048; it += NGW) swa_sample(it >> 4, it & 15, lane, a.in[I_CWK] + (size_t)l * 128 * 128 * 256, a.in[I_CWV] + (size_t)l * 128 * 128 * 256, out + O_SWK + (size_t)l * 128 * 128 * 256, out + O_SWV + (size_t)l * 128 * 128 * 256, ZQS_, sinks_l);
            for (int i = gw * 64 + lane; i < 2 * 128 * 127 * 64; i += NGW * 64) { const int which = i / (128 * 127 * 64), r = i % (128 * 127 * 64), bb = r / (127 * 64), rr = r % (127 * 64), j = rr >> 6, c4 = (rr & 63) * 4;
                const float* src = (which ? a.in[I_CWV] : a.in[I_CWK]) + (size_t)l * 128 * 128 * 256 + ((size_t)bb * 128 + j + 1) * 256 + c4;
                float* dst = out + (which ? O_SWV : O_SWK) + (size_t)l * 128 * 128 * 256 + ((size_t)bb * 128 + j) * 256 + c4; *(f32x4*)dst = *(const f32x4*)src; }
            __syncthreads();
#endif
#ifndef SK_LRU
            for (int it = bid; it < 256; it += G) lru_item(tid, lds, it >> 4, it & 15, LP, ZXR_, ZYA_, out + O_PCONV + (size_t)l * 16 * 3 * 1024, out + O_PH + (size_t)l * 16 * 1024);
#endif
#ifndef SK_SWA
            for (int it = bid; it < 1024; it += G) swa_item(tid, lds, it >> 6, (it >> 4) & 3, it & 15, ZKV_, VT_, ZQS_, sinks_l);
#endif
#ifndef SK_MEM
            for (int it = bid; it < 1024; it += G) mem_item(tid, lds, it >> 6, (it >> 4) & 3, it & 15, (const bf16_t*)(ws + WS_MKB) + (size_t)l * 4096 * DM, (const bf16_t*)(ws + WS_MVT) + (size_t)l * 4096 * DM, ZXC_);
#endif
        }
        PHASE_END
        PHASE_BEGIN
        { EpiBranch E{GT_, MG_}; BranchSched S{G, bid}; gemm_phase(tid, ldsl, ZYA_, (const bf16_t*)(ws + WS_WBR) + (size_t)l * 3072 * DM, DM, S, E); }
        PHASE_END
        PHASE_BEGIN
        { EpiRes E{l == 0 ? a.in[I_XP] : RF_, l == 0 ? a.in[I_XS] : RF_ + (size_t)MPR * 1024, Y_}; GridSched S; S.init(NTM, 4, G, bid, 0, 0); gemm_phase(tid, ldsl, MG_, (const bf16_t*)(ws + WS_WOUT) + (size_t)l * DM * DM, DM, S, E); }
        PHASE_END
        PHASE_BEGIN ln_phase(Y_, a.in[I_L1G] + l * 1024, a.in[I_L1B] + l * 1024, RF_, RB_, gw, NGW, lane); PHASE_END
        PHASE_BEGIN
        { EpiGLU E{HID_}; GridSched S; S.init(NTM, 22, G, bid, 0, 0); gemm_phase(tid, ldsl, RB_, (const bf16_t*)(ws + WS_WGU) + (size_t)l * 2 * DFF * DM, DM, S, E); }
        PHASE_END
        PHASE_BEGIN
        { EpiRes E{RF_, RF_ + (size_t)MPR * 1024, Y_}; GridSched S; S.init(NTM, 4, G, bid, 0, 0); gemm_phase(tid, ldsl, HID_, (const bf16_t*)(ws + WS_WDN) + (size_t)l * DM * DFF, DFF, S, E); }
        PHASE_END
        PHASE_BEGIN ln_phase(Y_, a.in[I_L2G] + l * 1024, a.in[I_L2B] + l * 1024, l == 1 ? out : RF_, RB_, gw, NGW, lane); PHASE_END
    }
}

constexpr int N_PHASES = 17;
#ifndef ONE_LAUNCH
#define ONE_LAUNCH 1
#endif
extern "C" void kernel_launch(void* const* d_in, const int* in_sizes, int n_in, void* d_out, int out_size, void* d_ws, size_t ws_size, hipStream_t stream) {
    constexpr int LDS_BYTES = 143360;
    static int grid = 0;
    if (grid == 0) {
        if (n_in != 28 || (size_t)out_size != O_END || ws_size < WS_END) { fprintf(stderr, "kernel_launch: unexpected sizes n_in %d out %d ws %zu (need %zu)\n", n_in, out_size, ws_size, (size_t)WS_END); grid = -1; return; }
        int dev = 0, cus = 0, per_cu = 0;
        (void)hipGetDevice(&dev);
        (void)hipDeviceGetAttribute(&cus, hipDeviceAttributeMultiprocessorCount, dev);
        (void)hipFuncSetAttribute((const void*)fwd_kernel, hipFuncAttributeMaxDynamicSharedMemorySize, LDS_BYTES);
        (void)hipOccupancyMaxActiveBlocksPerMultiprocessor(&per_cu, (const void*)fwd_kernel, 512, LDS_BYTES);
        if (per_cu < 1) per_cu = 1;
        grid = cus * per_cu;
        fprintf(stderr, "kernel_launch: grid %d (cus %d x %d), ws %zu need %zu\n", grid, cus, per_cu, ws_size, (size_t)WS_END);
    }
    if (grid < 0) return;
    Args a{};
    for (int i = 0; i < 28; ++i) a.in[i] = (const float*)d_in[i];
    a.out = (float*)d_out; a.ws = (unsigned char*)d_ws;
#if ONE_LAUNCH
    a.coop = 1; a.ph_lo = 0; a.ph_hi = N_PHASES;
    void* args[] = {&a};
    hipError_t e = hipLaunchCooperativeKernel((const void*)fwd_kernel, dim3(grid), dim3(512), args, LDS_BYTES, stream);
    if (e != hipSuccess) fprintf(stderr, "cooperative launch failed: %s (grid %d)\n", hipGetErrorString(e), grid);
#else
    a.coop = 0;
    for (int p = 0; p < N_PHASES; ++p) { a.ph_lo = p; a.ph_hi = p + 1; hipLaunchKernelGGL(fwd_kernel, dim3(grid), dim3(512), LDS_BYTES, stream, a); }
#endif
}
```

```cpp
#include <hip/hip_runtime.h>
#include <hip/hip_cooperative_groups.h>
#include <cstdio>
#include <cstdint>
namespace cg = cooperative_groups;

#define DI __device__ __forceinline__
#define LAS __attribute__((address_space(3)))
typedef unsigned short bf16_t;
typedef short bf16x8 __attribute__((ext_vector_type(8)));
typedef short s16x4 __attribute__((ext_vector_type(4)));
typedef float f32x4 __attribute__((ext_vector_type(4)));
typedef float f32x2 __attribute__((ext_vector_type(2)));
typedef unsigned u32x4 __attribute__((ext_vector_type(4)));
typedef unsigned u32x2 __attribute__((ext_vector_type(2)));
typedef __bf16 bf16x2_t __attribute__((ext_vector_type(2)));

DI unsigned pk2(float lo, float hi) { f32x2 v = {lo, hi}; bf16x2_t b = __builtin_convertvector(v, bf16x2_t); return __builtin_bit_cast(unsigned, b); }
DI bf16_t f2bf(float x) { return (bf16_t)(pk2(x, 0.f) & 0xffffu); }
DI float bf2f(bf16_t h) { return __uint_as_float(((unsigned)h) << 16); }
DI float bflo(unsigned w) { return __uint_as_float(w << 16); }
DI float bfhi(unsigned w) { return __uint_as_float(w & 0xffff0000u); }
DI float fexp2(float x) { return __builtin_amdgcn_exp2f(x); }
DI float frcp(float x) { return __builtin_amdgcn_rcpf(x); }
constexpr float LOG2E = 1.4426950408889634f;
DI float sigmoidf_(float x) { return frcp(1.f + fexp2(-x * LOG2E)); }
DI float gelu_tanh(float x) { const float y = 1.5957691216057308f * (x + 0.044715f * x * x * x); return x * sigmoidf_(y); }

constexpr int DM = 1024, NB = 16, SEQ = 2048, NS = 128, MPR = NB * SEQ, MREAL = MPR + NS, MT = 33024, NTM = MT / 256;
constexpr int INC = 7680, DFF = 2816, NMEM = 256;
constexpr float ALPHA = 1.4142135623730951f, LN_EPS = 1e-5f;
constexpr size_t O_YP = 0, O_YS = 33554432, O_PCONV = 33685504, O_PH = 33783808, O_PWK = 33816576, O_PWV = 34865152, O_PMK = 35913728, O_PMV = 44302336,
                 O_SCONV = 52690944, O_SH = 53477376, O_SWK = 53739520, O_SWV = 62128128, O_END = 70516736;
constexpr size_t WS_CTL = 0;
constexpr size_t WS_WIN = 1u << 20;
constexpr size_t WS_WMKV = WS_WIN + 2ull * INC * DM * 2;
constexpr size_t WS_WBR = WS_WMKV + 2ull * 2048 * DM * 2;
constexpr size_t WS_WOUT = WS_WBR + 2ull * 3072 * DM * 2;
constexpr size_t WS_WGU = WS_WOUT + 2ull * DM * DM * 2;
constexpr size_t WS_WDN = WS_WGU + 2ull * 2 * DFF * DM * 2;
constexpr size_t WS_RB = WS_WDN + 2ull * DM * DFF * 2;
constexpr size_t WS_RF = WS_RB + (size_t)MT * DM * 2;
constexpr size_t COLB = (size_t)MT * DM * 2;
constexpr size_t WS_ZYA = WS_RF + (size_t)MT * DM * 4;
constexpr size_t WS_ZQS = WS_ZYA + COLB, WS_ZXC = WS_ZQS + COLB, WS_ZXR = WS_ZXC + COLB, WS_ZKV = WS_ZXR + COLB;
constexpr size_t WS_GT = WS_ZKV + (size_t)MT * 512 * 2;
constexpr size_t WS_MG = WS_GT + (size_t)MT * 3072 * 2;
constexpr size_t WS_VT = WS_MG + COLB;
constexpr size_t WS_MKB = WS_VT + 256ull * MT * 2;
constexpr size_t WS_MVT = WS_MKB + 2ull * 4096 * DM * 2;
constexpr size_t WS_MPB = WS_MVT + 2ull * 4096 * DM * 2;
constexpr size_t WS_END = WS_MPB + 4096ull * DM * 2;
static_assert((size_t)MT * DFF * 2 <= WS_GT - WS_ZYA, "HID overlay");

constexpr int BM = 256, BK = 64, HALF = 128, HTB = HALF * BK * 2, STAGE_BYTES = 8 * HTB;
DI int lds_byte(int r, int c) { const int st = (r >> 4) * 2 + (c >> 5), rr = r & 15, cc = c & 31, ob = rr * 64 + cc * 2; return st * 1024 + (ob ^ (((ob >> 9) & 1) << 5)); }
DI void stage_rc(int b, int& R, int& C) { const int st = b / 1024, sb = b % 1024, swz = sb ^ (((sb >> 9) & 1) << 5); R = (st >> 1) * 16 + swz / 64; C = (st & 1) * 32 + (swz % 64) / 2; }
struct Unit { int pa, pb, pm, pn, aux; };
struct GridSched {
    int nM, nN, nwg, G, c, a0, b0;
    DI void init(int nM_, int nN_, int G_, int c_, int a0_, int b0_) { nM = nM_; nN = nN_; nwg = nM * nN; G = G_; c = c_; a0 = a0_; b0 = b0_; }
    DI bool next(int i, Unit& u) const {
        const long L = (long)i * G + c; if (L >= nwg) return false;
        int wgid = (int)L; { const int q = nwg / 8, r = nwg % 8, xcd = wgid % 8, off = wgid / 8; wgid = (xcd < r ? xcd * (q + 1) : r * (q + 1) + (xcd - r) * q) + off; }
        const int nig = 8 * nN, gid = wgid / nig, fm = gid * 8, gsz = (nM - fm) < 8 ? (nM - fm) : 8;
        u.pm = fm + ((wgid % nig) % gsz); u.pn = (wgid % nig) / gsz; u.pa = a0 + u.pm; u.pb = b0 + u.pn; u.aux = 0; return true;
    }
};
struct BranchSched {
    int G, c;
    DI bool next(int i, Unit& u) const {
        const int T = (i / 3) * G + c; if (T >= NTM * 4) return false;
        const int n = i % 3; u.pm = T >> 2; u.pn = T & 3; u.pa = n * NTM + u.pm; u.pb = n * 4 + u.pn; u.aux = n; return true;
    }
};

template <class Epi, class Sched>
DI void gemm_phase(const int tid, LAS unsigned char* lds, const bf16_t* gA, const bf16_t* gB, const int K, const Sched& S, const Epi& E) {
    const int wid = __builtin_amdgcn_readfirstlane(tid >> 6), lane = tid & 63, wr = wid >> 2, wc = wid & 3, fr = lane & 15, fq = lane >> 4;
    const int nt = K / BK;
    unsigned voff[2];
#pragma unroll
    for (int i = 0; i < 2; ++i) { int R, C; stage_rc(tid * 16 + i * 8192, R, C); voff[i] = (unsigned)(R * K + C) * 2u; }
    const size_t kstep = (size_t)(BK * 2);
    const size_t hstep = (size_t)HALF * K * 2;
    const size_t tstep = 2 * hstep;
    const unsigned ldsw = (unsigned)wid * 1024u;
    const int aoff = lds_byte(wr * 64 + fr, fq * 8), boff = lds_byte(wc * 32 + fr, fq * 8);
#define PG8_SA(b, h) (((b) * 2 + (h)) * HTB)
#define PG8_SB(b, h) ((4 + (b) * 2 + (h)) * HTB)
#define PG8_STAGE(bufoff, gbase) do { _Pragma("unroll") for (int _i = 0; _i < 2; ++_i) \
        __builtin_amdgcn_global_load_lds((const unsigned*)((const char*)(gbase) + voff[_i]), (LAS unsigned*)(lds + (bufoff) + ldsw + _i * 8192), 16, 0, 0); } while (0)
#define PG8_LDA(dst, b, h) do { _Pragma("unroll") for (int m = 0; m < 4; ++m) _Pragma("unroll") for (int k = 0; k < 2; ++k) dst[m][k] = *(const LAS bf16x8*)(lds + PG8_SA(b, h) + aoff + m * 2048 + k * 1024); } while (0)
#define PG8_LDB(dst, b, h) do { _Pragma("unroll") for (int n = 0; n < 2; ++n) _Pragma("unroll") for (int k = 0; k < 2; ++k) dst[n][k] = *(const LAS bf16x8*)(lds + PG8_SB(b, h) + boff + n * 2048 + k * 1024); } while (0)
#define PG8_MMA(ai, bj, At, Bt) do { __builtin_amdgcn_s_setprio(1); _Pragma("unroll") for (int m = 0; m < 4; ++m) _Pragma("unroll") for (int n = 0; n < 2; ++n) _Pragma("unroll") for (int k = 0; k < 2; ++k) \
        acc[ai][bj][m][n] = __builtin_amdgcn_mfma_f32_16x16x32_bf16(Bt[n][k], At[m][k], acc[ai][bj][m][n], 0, 0, 0); __builtin_amdgcn_s_setprio(0); } while (0)
#define PG8_WAIT_V(n) asm volatile("s_waitcnt vmcnt(" #n ")" ::: "memory")
#define PG8_WAIT_L(n) asm volatile("s_waitcnt lgkmcnt(" #n ")" ::: "memory")
#define PG8_BAR __builtin_amdgcn_s_barrier()
#define PG8_SCHED __builtin_amdgcn_sched_barrier(0)
    Unit cur, nxt; int ui = 0;
    if (!S.next(0, cur)) return;
    f32x4 acc[2][2][4][2];
#pragma unroll
    for (int a = 0; a < 2; ++a)
#pragma unroll
        for (int b = 0; b < 2; ++b)
#pragma unroll
            for (int m = 0; m < 4; ++m)
#pragma unroll
                for (int n = 0; n < 2; ++n) acc[a][b][m][n] = (f32x4){0.f, 0.f, 0.f, 0.f};
    bf16x8 At[4][2], B0[2][2], B1[2][2];
    const char* cA = (const char*)gA + (size_t)cur.pa * tstep; const char* cB = (const char*)gB + (size_t)cur.pb * tstep;
    PG8_STAGE(PG8_SB(0, 0), cB); PG8_STAGE(PG8_SB(0, 1), cB + hstep); PG8_STAGE(PG8_SA(0, 0), cA); PG8_STAGE(PG8_SA(0, 1), cA + hstep);
    if (wr == 1) PG8_BAR;
    PG8_WAIT_V(2); PG8_BAR;
    PG8_STAGE(PG8_SB(1, 0), cB + kstep); PG8_STAGE(PG8_SA(1, 0), cA + kstep); PG8_STAGE(PG8_SB(1, 1), cB + hstep + kstep);
    PG8_WAIT_V(6); PG8_BAR;
    for (;;) {
        const bool has_next = S.next(ui + 1, nxt);
        const char* nA = has_next ? (const char*)gA + (size_t)nxt.pa * tstep : cA; const char* nB = has_next ? (const char*)gB + (size_t)nxt.pb * tstep : cB;
        for (int t = 0; t < nt; t += 2) {
            const bool last = (t == nt - 2);
            const char* a1 = cA + (size_t)(t + 1) * kstep;
            const char* a2 = last ? nA : cA + (size_t)(t + 2) * kstep; const char* b2 = last ? nB : cB + (size_t)(t + 2) * kstep;
            const char* a3 = a2 + kstep; const char* b3 = b2 + kstep;
            PG8_LDB(B0, 0, 0); PG8_LDB(B1, 0, 1); PG8_SCHED; PG8_LDA(At, 0, 0); PG8_STAGE(PG8_SA(1, 1), a1 + hstep);
            PG8_WAIT_V(8); PG8_WAIT_L(0); PG8_BAR; PG8_MMA(0, 0, At, B0); PG8_MMA(0, 1, At, B1); PG8_BAR; PG8_SCHED;
            PG8_LDA(At, 0, 1); PG8_STAGE(PG8_SB(0, 0), b2); PG8_STAGE(PG8_SB(0, 1), b2 + hstep); PG8_STAGE(PG8_SA(0, 0), a2);
            PG8_WAIT_V(8); PG8_WAIT_L(0); PG8_BAR; PG8_MMA(1, 0, At, B0); PG8_MMA(1, 1, At, B1); PG8_BAR; PG8_SCHED;
            PG8_LDB(B0, 1, 0); PG8_LDB(B1, 1, 1); PG8_SCHED; PG8_LDA(At, 1, 0); PG8_STAGE(PG8_SA(0, 1), a2 + hstep);
            PG8_WAIT_V(8); PG8_WAIT_L(0); PG8_BAR; PG8_MMA(0, 0, At, B0); PG8_MMA(0, 1, At, B1); PG8_BAR; PG8_SCHED;
            PG8_LDA(At, 1, 1); PG8_STAGE(PG8_SB(1, 0), b3); PG8_STAGE(PG8_SB(1, 1), b3 + hstep); PG8_STAGE(PG8_SA(1, 0), a3);
            PG8_WAIT_V(8); PG8_WAIT_L(0); PG8_BAR; PG8_MMA(1, 0, At, B0); PG8_MMA(1, 1, At, B1); PG8_BAR; PG8_SCHED;
        }
        if (wr == 0) PG8_BAR;
        E(acc, cur, wr, wc, fr, fq);
        if (!has_next) break;
#pragma unroll
        for (int a = 0; a < 2; ++a)
#pragma unroll
            for (int b = 0; b < 2; ++b)
#pragma unroll
                for (int m = 0; m < 4; ++m)
#pragma unroll
                    for (int n = 0; n < 2; ++n) acc[a][b][m][n] = (f32x4){0.f, 0.f, 0.f, 0.f};
        cur = nxt; cA = nA; cB = nB; ++ui;
        if (wr == 1) PG8_BAR;
    }
    PG8_WAIT_V(0);
    PG8_BAR;
#undef PG8_SA
#undef PG8_SB
#undef PG8_STAGE
#undef PG8_LDA
#undef PG8_LDB
#undef PG8_MMA
#undef PG8_WAIT_V
#undef PG8_WAIT_L
#undef PG8_BAR
#undef PG8_SCHED
}
#define EPI_LOOP(BODY) _Pragma("unroll") for (int ai = 0; ai < 2; ++ai) _Pragma("unroll") for (int m = 0; m < 4; ++m) { const int row = u.pm * 256 + ai * 128 + wr * 64 + m * 16 + fr; \
    _Pragma("unroll") for (int bj = 0; bj < 2; ++bj) _Pragma("unroll") for (int n = 0; n < 2; ++n) { const int col = bj * 128 + wc * 32 + n * 16 + 4 * fq; const f32x4 v = acc[ai][bj][m][n]; BODY } }
DI void st_bf4(bf16_t* p, f32x4 v) { u32x2 w; w.x = pk2(v[0], v[1]); w.y = pk2(v[2], v[3]); *(u32x2*)p = w; }

struct EpiPlain { bf16_t* O; int ldc;
    DI void operator()(const f32x4 (&acc)[2][2][4][2], const Unit& u, int wr, int wc, int fr, int fq) const { EPI_LOOP( st_bf4(O + (size_t)row * ldc + u.pn * 256 + col, v); ) } };
struct EpiMem { float* pk; float* pv; bf16_t* mkb;
    DI void operator()(const f32x4 (&acc)[2][2][4][2], const Unit& u, int wr, int wc, int fr, int fq) const {
        const bool isk = u.pn < 4; float* dst = isk ? pk : pv; const int c0 = (u.pn & 3) * 256;
        EPI_LOOP( *(f32x4*)(dst + (size_t)row * 1024 + c0 + col) = v; if (isk) st_bf4(mkb + (size_t)row * 1024 + c0 + col, v); ) } };
struct EpiIn { unsigned char* ws; float* out; const float* bg; int l;
    DI void operator()(const f32x4 (&acc)[2][2][4][2], const Unit& u, int wr, int wc, int fr, int fq) const {
        const int pn = u.pn; size_t boff; int ldc = 1024, c0, mode; float sc = 1.f;
        if (pn < 4) { boff = WS_ZXR; c0 = pn * 256; mode = 0; }
        else if (pn < 8) { boff = WS_ZYA; c0 = (pn - 4) * 256; mode = 1; }
        else if (pn < 12) { boff = WS_ZQS; c0 = (pn - 8) * 256; mode = 2; sc = 0.125f * LOG2E; }
        else if (pn < 14) { boff = WS_ZKV; ldc = 512; c0 = (pn - 12) * 256; mode = 4; }
        else if (pn < 18) { boff = WS_ZXC; c0 = (pn - 14) * 256; mode = 2; sc = 0.0625f * LOG2E; }
        else { boff = WS_GT; ldc = 3072; c0 = (pn - 18) * 256; mode = 3; }
        bf16_t* base = (bf16_t*)(ws + boff);
        float* pw = out + ((pn == 12) ? O_PWK : O_PWV) + (size_t)l * 16 * 128 * 256; float* sw = out + ((pn == 12) ? O_SWK : O_SWV) + (size_t)l * 128 * 128 * 256;
        EPI_LOOP(
            f32x4 o = v;
            if (mode == 1) { o[0] = gelu_tanh(v[0]); o[1] = gelu_tanh(v[1]); o[2] = gelu_tanh(v[2]); o[3] = gelu_tanh(v[3]); }
            else if (mode == 2) { o = v * sc; }
            else if (mode == 3) { const f32x4 bb = *(const f32x4*)(bg + c0 + col); o[0] = sigmoidf_(v[0] + bb[0]); o[1] = sigmoidf_(v[1] + bb[1]); o[2] = sigmoidf_(v[2] + bb[2]); o[3] = sigmoidf_(v[3] + bb[3]); }
            else if (mode == 4) {
                if (row < MPR) { const int t = row & (SEQ - 1); if (t >= SEQ - 128) *(f32x4*)(pw + ((size_t)((row >> 11) * 128 + (t - (SEQ - 128))) * 256 + col)) = v; }
                else if (row < MREAL) { *(f32x4*)(sw + ((size_t)((row - MPR) * 128 + 127) * 256 + col)) = v; }
            }
            st_bf4(base + (size_t)row * ldc + c0 + col, o); ) } };
struct EpiBranch { const bf16_t* gt; bf16_t* mg;
    DI void operator()(const f32x4 (&acc)[2][2][4][2], const Unit& u, int wr, int wc, int fr, int fq) const {
        const int nb = u.aux, c0 = u.pn * 256;
        EPI_LOOP(
            const u32x2 g = *(const u32x2*)(gt + (size_t)row * 3072 + nb * 1024 + c0 + col);
            f32x4 o; o[0] = bflo(g.x) * v[0]; o[1] = bfhi(g.x) * v[1]; o[2] = bflo(g.y) * v[2]; o[3] = bfhi(g.y) * v[3];
            bf16_t* p = mg + (size_t)row * 1024 + c0 + col;
            if (nb > 0) { const u32x2 q = *(const u32x2*)p; o[0] += bflo(q.x); o[1] += bfhi(q.x); o[2] += bflo(q.y); o[3] += bfhi(q.y); }
            st_bf4(p, o); ) } };
struct EpiRes { const float* resP; const float* resS; float* Y;
    DI void operator()(const f32x4 (&acc)[2][2][4][2], const Unit& u, int wr, int wc, int fr, int fq) const {
        const int c0 = u.pn * 256;
        EPI_LOOP(
            if (row < MREAL) { const float* rp = (row < MPR) ? resP + (size_t)row * 1024 : resS + (size_t)(row - MPR) * 1024;
                const f32x4 r = *(const f32x4*)(rp + c0 + col); *(f32x4*)(Y + (size_t)row * 1024 + c0 + col) = r * ALPHA + v; } ) } };
struct EpiGLU { bf16_t* hid;
    DI void operator()(const f32x4 (&acc)[2][2][4][2], const Unit& u, int wr, int wc, int fr, int fq) const {
#pragma unroll
        for (int ai = 0; ai < 2; ++ai)
#pragma unroll
            for (int m = 0; m < 4; ++m) { const int row = u.pm * 256 + ai * 128 + wr * 64 + m * 16 + fr;
#pragma unroll
                for (int n = 0; n < 2; ++n) { const int col = u.pn * 128 + wc * 32 + n * 16 + 4 * fq; const f32x4 g = acc[ai][0][m][n], up = acc[ai][1][m][n]; f32x4 o;
                    o[0] = g[0] * sigmoidf_(g[0]) * up[0]; o[1] = g[1] * sigmoidf_(g[1]) * up[1]; o[2] = g[2] * sigmoidf_(g[2]) * up[2]; o[3] = g[3] * sigmoidf_(g[3]) * up[3];
                    st_bf4(hid + (size_t)row * DFF + col, o); } } } };

DI float wave_sum(float v) {
#pragma unroll
    for (int o = 1; o < 64; o <<= 1) v += __shfl_xor(v, o);
    return v;
}
DI float wave_max(float v) {
#pragma unroll
    for (int o = 1; o < 64; o <<= 1) v = fmaxf(v, __shfl_xor(v, o));
    return v;
}
DI void transpose_item(const float* W, int ldw, int src_col0, int k0, bf16_t* WT, int ldk, int dst_row0, float* scr, int lane) {
#pragma unroll 8
    for (int i = 0; i < 32; ++i) { const int kk = 2 * i + (lane >> 5); scr[kk * 33 + (lane & 31)] = W[(size_t)(k0 + kk) * ldw + src_col0 + (lane & 31)]; }
    asm volatile("s_waitcnt lgkmcnt(0)" ::: "memory");
    const int c = lane & 7;
#pragma unroll
    for (int j = 0; j < 4; ++j) { const int n = (lane >> 3) + 8 * j; const float* s = scr + (8 * c) * 33 + n;
        u32x4 o; o.x = pk2(s[0 * 33], s[1 * 33]); o.y = pk2(s[2 * 33], s[3 * 33]); o.z = pk2(s[4 * 33], s[5 * 33]); o.w = pk2(s[6 * 33], s[7 * 33]);
        *(u32x4*)(WT + (size_t)(dst_row0 + n) * ldk + k0 + 8 * c) = o; }
    asm volatile("s_waitcnt lgkmcnt(0)" ::: "memory");
}


#define XB_TMO      128
#define XB_XCNT(j)  (256  + 64 * (j))
#define XB_XSUB(j)  (1280 + 64 * (j))
#define XB_XGEN(j)  (2304 + 64 * (j))
#define XB_TOP      3328
#define XB_TOPGEN   3392
#define XCD_BAR_WORDS 3456
#define XB_SPIN_CAP (1u << 22)
DI unsigned xb_ld(unsigned* p)              { return __hip_atomic_load(p, __ATOMIC_RELAXED, __HIP_MEMORY_SCOPE_AGENT); }
DI unsigned xb_add(unsigned* p, unsigned v) { return __hip_atomic_fetch_add(p, v, __ATOMIC_RELAXED, __HIP_MEMORY_SCOPE_AGENT); }
DI unsigned xb_xcc_id() { return (unsigned)__builtin_amdgcn_s_getreg((3 << 11) | 20) & 0xFu; }
#define XB_SPIN(cond, bar) do { unsigned _sp = 0; while (cond) { __builtin_amdgcn_s_sleep(1); \
    if ((++_sp & 255u) == 0u) { if (xb_ld(&(bar)[XB_TMO])) break; if (_sp > XB_SPIN_CAP) { atomicAdd(&(bar)[XB_TMO], 1u); break; } } } } while (0)
DI void xcd_barrier_complete(unsigned* bar, unsigned x, unsigned& nloc, unsigned& nx) {
    const unsigned G = gridDim.x;
    unsigned sum, cnt, mine, sp = 0u;
    for (;;) {
        sum = 0u; cnt = 0u; mine = 0u;
#pragma unroll
        for (unsigned j = 0; j < 16; ++j) { const unsigned c = xb_ld(&bar[XB_XCNT(j)]); sum += c; cnt += (c > 0u) ? 1u : 0u; mine = (j == x) ? c : mine; }
        if (sum == G) break;
        __builtin_amdgcn_s_sleep(1);
        if ((++sp & 255u) == 0u) { if (xb_ld(&bar[XB_TMO])) break; if (sp > XB_SPIN_CAP) { atomicAdd(&bar[XB_TMO], 1u); break; } }
    }
    nloc = mine > 0u ? mine : 1u; nx = cnt > 0u ? cnt : 1u;
}
DI void xcd_barrier(unsigned* bar, volatile LAS unsigned* st, const int tid) {
    asm volatile("s_waitcnt vmcnt(0)" ::: "memory");
    __syncthreads();
    if (tid == 0) {
        __builtin_amdgcn_s_waitcnt(0);
        const unsigned x = xb_xcc_id();
        unsigned nloc = st[0], nx = st[1];
        if (nloc == 0u) { xcd_barrier_complete(bar, x, nloc, nx); st[0] = nloc; st[1] = nx; }
        const unsigned old = xb_add(&bar[XB_XSUB(x)], 1u);
        const unsigned gen = old / nloc;
        if (old + 1u == (gen + 1u) * nloc) {
            __builtin_amdgcn_fence(__ATOMIC_RELEASE, "agent");
            asm volatile("s_waitcnt vmcnt(0)" ::: "memory");
            const unsigned og = xb_add(&bar[XB_TOP], 1u);
            const unsigned tg = og / nx;
            if (og + 1u == (tg + 1u) * nx) xb_add(&bar[XB_TOPGEN], 1u);
            else XB_SPIN(xb_ld(&bar[XB_TOPGEN]) == tg, bar);
            __builtin_amdgcn_fence(__ATOMIC_ACQUIRE, "agent");
            xb_add(&bar[XB_XGEN(x)], 1u);
            asm volatile("s_waitcnt vmcnt(0)" ::: "memory");
        } else {
            XB_SPIN(xb_ld(&bar[XB_XGEN(x)]) == gen, bar);
            __builtin_amdgcn_fence(__ATOMIC_ACQUIRE, "agent");
            asm volatile("s_waitcnt vmcnt(0)" ::: "memory");
        }
    }
    __syncthreads();
}
constexpr int MISC_OFF = 141312;

struct Args { const float* in[28]; float* out; unsigned char* ws; int ph_lo, ph_hi, coop, pad; };
enum { I_XP = 0, I_XS, I_SCONV, I_SH, I_CWK, I_CWV, I_CMK, I_CMV, I_MEMP, I_WMKV, I_WIN, I_BG, I_CW, I_CB, I_WA, I_BA, I_WX, I_BX, I_LAM, I_SINK, I_WBR, I_WOUT, I_L1G, I_L1B, I_WGU, I_WDN, I_L2G, I_L2B };

DI void prologue(const Args& a, unsigned char* lds, int gw, int NGW, int lane, int wave) {
    unsigned char* ws = a.ws;
    float* scr = (float*)(lds + wave * 16384);
    constexpr int N_IN = 16 * 240, N_MK = 16 * 64, N_BR = 3 * 16 * 32, N_OUT = 16 * 32, N_GU = 16 * 176, N_DN = 44 * 32, N_L = N_IN + N_MK + N_BR + N_OUT + N_GU + N_DN;
    for (int it = gw; it < 2 * N_L; it += NGW) {
        const int l = it / N_L; int r = it % N_L;
        if (r < N_IN) { const int kb = r / 240, nb = r % 240; transpose_item(a.in[I_WIN] + (size_t)l * DM * INC, INC, 32 * nb, 64 * kb, (bf16_t*)(ws + WS_WIN) + (size_t)l * INC * DM, DM, 32 * nb, scr, lane); continue; } r -= N_IN;
        if (r < N_MK) { const int kb = r / 64, nb = r % 64; transpose_item(a.in[I_WMKV] + (size_t)l * DM * 2048, 2048, 32 * nb, 64 * kb, (bf16_t*)(ws + WS_WMKV) + (size_t)l * 2048 * DM, DM, 32 * nb, scr, lane); continue; } r -= N_MK;
        if (r < N_BR) { const int n = r / 512, rr = r % 512, kb = rr / 32, nb = rr % 32; transpose_item(a.in[I_WBR] + (size_t)(l * 3 + n) * DM * DM, DM, 32 * nb, 64 * kb, (bf16_t*)(ws + WS_WBR) + (size_t)l * 3072 * DM, DM, n * 1024 + 32 * nb, scr, lane); continue; } r -= N_BR;
        if (r < N_OUT) { const int kb = r / 32, nb = r % 32; transpose_item(a.in[I_WOUT] + (size_t)l * DM * DM, DM, 32 * nb, 64 * kb, (bf16_t*)(ws + WS_WOUT) + (size_t)l * DM * DM, DM, 32 * nb, scr, lane); continue; } r -= N_OUT;
        if (r < N_GU) { const int kb = r / 176, nb = r % 176, dr = 32 * nb, pn = dr >> 8, half = (dr >> 7) & 1, cc = dr & 127;
            transpose_item(a.in[I_WGU] + (size_t)l * DM * 2 * DFF, 2 * DFF, half * DFF + 128 * pn + cc, 64 * kb, (bf16_t*)(ws + WS_WGU) + (size_t)l * 2 * DFF * DM, DM, dr, scr, lane); continue; } r -= N_GU;
        { const int kb = r / 32, nb = r % 32; transpose_item(a.in[I_WDN] + (size_t)l * DFF * DM, DM, 32 * nb, 64 * kb, (bf16_t*)(ws + WS_WDN) + (size_t)l * DM * DFF, DFF, 32 * nb, scr, lane); }
    }
    const int gt_ = gw * 64 + lane, GT_ = NGW * 64;
    bf16_t* rb = (bf16_t*)(ws + WS_RB);
    for (int i = gt_; i < MT * 128; i += GT_) { const int row = i >> 7, c8 = (i & 127) * 8; u32x4 o = {0u, 0u, 0u, 0u};
        if (row < MREAL) { const float* s = (row < MPR ? a.in[I_XP] + (size_t)row * 1024 : a.in[I_XS] + (size_t)(row - MPR) * 1024) + c8; const f32x4 v0 = *(const f32x4*)s, v1 = *(const f32x4*)(s + 4);
            o.x = pk2(v0[0], v0[1]); o.y = pk2(v0[2], v0[3]); o.z = pk2(v1[0], v1[1]); o.w = pk2(v1[2], v1[3]); }
        *(u32x4*)(rb + (size_t)row * 1024 + c8) = o; }
    bf16_t* mpb = (bf16_t*)(ws + WS_MPB);
    for (int i = gt_; i < 4096 * 128; i += GT_) { const float* s = a.in[I_MEMP] + (size_t)i * 8; const f32x4 v0 = *(const f32x4*)s, v1 = *(const f32x4*)(s + 4); u32x4 o;
        o.x = pk2(v0[0], v0[1]); o.y = pk2(v0[2], v0[3]); o.z = pk2(v1[0], v1[1]); o.w = pk2(v1[2], v1[3]); *(u32x4*)(mpb + (size_t)i * 8) = o; }
}

DI void ln_phase(const float* Y, const float* g, const float* bt, float* outF, bf16_t* outB, int gw, int NGW, int lane) {
    f32x4 gv[4], bv[4];
#pragma unroll
    for (int j = 0; j < 4; ++j) { gv[j] = *(const f32x4*)(g + 4 * lane + 256 * j); bv[j] = *(const f32x4*)(bt + 4 * lane + 256 * j); }
    for (int row = gw; row < MREAL; row += NGW) {
        const float* y = Y + (size_t)row * 1024 + 4 * lane; f32x4 v[4]; float s = 0.f;
#pragma unroll
        for (int j = 0; j < 4; ++j) { v[j] = *(const f32x4*)(y + 256 * j); s += (v[j][0] + v[j][1]) + (v[j][2] + v[j][3]); }
        const float mean = wave_sum(s) * (1.f / 1024.f); float s2 = 0.f;
#pragma unroll
        for (int j = 0; j < 4; ++j) { v[j] = v[j] - mean; s2 += (v[j][0] * v[j][0] + v[j][1] * v[j][1]) + (v[j][2] * v[j][2] + v[j][3] * v[j][3]); }
        const float rstd = 1.f / sqrtf(wave_sum(s2) * (1.f / 1024.f) + LN_EPS);
#pragma unroll
        for (int j = 0; j < 4; ++j) { const f32x4 o = v[j] * rstd * gv[j] + bv[j]; *(f32x4*)(outF + (size_t)row * 1024 + 4 * lane + 256 * j) = o; st_bf4(outB + (size_t)row * 1024 + 4 * lane + 256 * j, o); }
    }
}

struct LruP { const float *cw, *cb, *wa, *ba, *wx, *bx, *lam; };
DI void lru_gate(float rpre, float ipre, float xc, float nsp, float& a, float& uu) {
    const float r = sigmoidf_(rpre), ig = sigmoidf_(ipre);
    const float la = nsp * r;
    a = __expf(la); uu = sqrtf(fmaxf(-expm1f(2.f * la), 0.f)) * (ig * xc);
}
DI void lru_item(const int tid, unsigned char* lds, int b, int blk, const LruP& P, const bf16_t* zxr, const bf16_t* zya, bf16_t* zo, float* pconv_l, float* ph_l) {
    const int lane = tid & 63, w = tid >> 6, fr = lane & 15, fq = lane >> 4, c = blk * 64 + lane;
    bf16_t* xcs = (bf16_t*)lds + w * 16 * 72;
    float* rp = (float*)(lds + 18432) + w * 16 * 68;
    float* ip = (float*)(lds + 18432 + 34816) + w * 16 * 68;
    float* tot = (float*)(lds + 18432 + 2 * 34816);
    const float cw0 = P.cw[c], cw1 = P.cw[1024 + c], cw2 = P.cw[2048 + c], cw3 = P.cw[3072 + c], cb = P.cb[c], ba = P.ba[c], bx = P.bx[c];
    const float nsp = -8.f * log1pf(__expf(-P.lam[c]));
    bf16x8 Ba[4][2], Bx[4][2];
#pragma unroll
    for (int nt = 0; nt < 4; ++nt)
#pragma unroll
        for (int ks = 0; ks < 2; ++ks)
#pragma unroll
            for (int e = 0; e < 8; ++e) { const int i = 32 * ks + 8 * fq + e, j = 16 * nt + fr;
                Ba[nt][ks][e] = (short)f2bf(P.wa[((size_t)blk * 64 + i) * 64 + j]); Bx[nt][ks][e] = (short)f2bf(P.wx[((size_t)blk * 64 + i) * 64 + j]); }
    float carry = 0.f; int par = 0;
    for (int chunk = 0; chunk < 16; ++chunk) {
        const int t0 = chunk * 128 + 16 * w; const size_t rowbase = (size_t)b * SEQ + t0;
        float x[19], gy[16];
#pragma unroll
        for (int k = 0; k < 19; ++k) x[k] = (t0 + k - 3 >= 0) ? bf2f(zxr[(rowbase + k - 3) * 1024 + c]) : 0.f;
#pragma unroll
        for (int t = 0; t < 16; ++t) gy[t] = bf2f(zya[(rowbase + t) * 1024 + c]);
        float xc[16];
#pragma unroll
        for (int t = 0; t < 16; ++t) { xc[t] = cb + cw0 * x[t] + cw1 * x[t + 1] + cw2 * x[t + 2] + cw3 * x[t + 3]; xcs[t * 72 + lane] = f2bf(xc[t]); }
        const bf16x8 A0 = *(const bf16x8*)&xcs[fr * 72 + 8 * fq], A1 = *(const bf16x8*)&xcs[fr * 72 + 32 + 8 * fq];
#pragma unroll
        for (int nt = 0; nt < 4; ++nt) {
            f32x4 r = __builtin_amdgcn_mfma_f32_16x16x32_bf16(A0, Ba[nt][0], (f32x4){0.f, 0.f, 0.f, 0.f}, 0, 0, 0); r = __builtin_amdgcn_mfma_f32_16x16x32_bf16(A1, Ba[nt][1], r, 0, 0, 0);
            f32x4 q = __builtin_amdgcn_mfma_f32_16x16x32_bf16(A0, Bx[nt][0], (f32x4){0.f, 0.f, 0.f, 0.f}, 0, 0, 0); q = __builtin_amdgcn_mfma_f32_16x16x32_bf16(A1, Bx[nt][1], q, 0, 0, 0);
#pragma unroll
            for (int j = 0; j < 4; ++j) { rp[(4 * fq + j) * 68 + 16 * nt + fr] = r[j]; ip[(4 * fq + j) * 68 + 16 * nt + fr] = q[j]; }
        }
        float Hs[16], Ps[16]; float Hc = 0.f, Pc = 1.f;
#pragma unroll
        for (int t = 0; t < 16; ++t) { float av, uv; lru_gate(rp[t * 68 + lane] + ba, ip[t * 68 + lane] + bx, xc[t], nsp, av, uv); Hc = av * Hc + uv; Pc = av * Pc; Hs[t] = Hc; Ps[t] = Pc; }
        tot[((par * 8 + w) * 64 + lane) * 2 + 0] = Pc; tot[((par * 8 + w) * 64 + lane) * 2 + 1] = Hc;
        __syncthreads();
        float h = carry, hin = 0.f;
#pragma unroll
        for (int w2 = 0; w2 < 8; ++w2) { const float p = tot[((par * 8 + w2) * 64 + lane) * 2 + 0], hh = tot[((par * 8 + w2) * 64 + lane) * 2 + 1]; if (w2 == w) hin = h; h = p * h + hh; }
        carry = h; par ^= 1;
#pragma unroll
        for (int t = 0; t < 16; ++t) zo[(rowbase + t) * 1024 + c] = f2bf((Hs[t] + Ps[t] * hin) * gy[t]);
        if (chunk == 15 && w == 7) {
#pragma unroll
            for (int k = 0; k < 3; ++k) pconv_l[((size_t)b * 3 + k) * 1024 + c] = x[16 + k];
        }
    }
    if (w == 0) ph_l[(size_t)b * 1024 + c] = carry;
    __syncthreads();
}
DI void lru_sample(int b, int blk, int lane, const LruP& P, const bf16_t* zxr, const bf16_t* zya, bf16_t* zo, const float* sconv_l, const float* sh_l, float* oconv_l, float* oh_l) {
    const int c = blk * 64 + lane; const size_t row = (size_t)MPR + b;
    const float xn = bf2f(zxr[row * 1024 + c]);
    const float s0 = sconv_l[((size_t)b * 3 + 0) * 1024 + c], s1 = sconv_l[((size_t)b * 3 + 1) * 1024 + c], s2 = sconv_l[((size_t)b * 3 + 2) * 1024 + c];
    const float xc = P.cb[c] + P.cw[c] * s0 + P.cw[1024 + c] * s1 + P.cw[2048 + c] * s2 + P.cw[3072 + c] * xn;
    float rpre = P.ba[c], ipre = P.bx[c];
#pragma unroll 8
    for (int i = 0; i < 64; ++i) { const float xi = __shfl(xc, i); rpre += xi * P.wa[((size_t)blk * 64 + i) * 64 + lane]; ipre += xi * P.wx[((size_t)blk * 64 + i) * 64 + lane]; }
    const float nsp = -8.f * log1pf(__expf(-P.lam[c]));
    float av, uv; lru_gate(rpre, ipre, xc, nsp, av, uv);
    const float h = av * sh_l[(size_t)b * 1024 + c] + uv;
    zo[row * 1024 + c] = f2bf(h * bf2f(zya[row * 1024 + c]));
    oconv_l[((size_t)b * 3 + 0) * 1024 + c] = s1; oconv_l[((size_t)b * 3 + 1) * 1024 + c] = s2; oconv_l[((size_t)b * 3 + 2) * 1024 + c] = xn;
    oh_l[(size_t)b * 1024 + c] = h;
}

DI void swa_item(const int tid, unsigned char* lds, int b, int kvh, int qb, const bf16_t* zkv, const bf16_t* vt, const bf16_t* zqs, bf16_t* zo, const float* sinks_l) {
    const int lane = tid & 63, w = tid >> 6, fr = lane & 15, fq = lane >> 4;
    bf16_t* Ks = (bf16_t*)lds;
    bf16_t* Vs = (bf16_t*)(lds + 36864);
#pragma unroll
    for (int i = 0; i < 4; ++i) { const int ch = tid + 512 * i;
        { const int r = ch >> 3, c8 = ch & 7; const int tok = (qb == 0 && r < 128) ? r : 128 * (qb - 1) + r;
          *(u32x4*)&Ks[r * 72 + c8 * 8] = *(const u32x4*)&zkv[((size_t)b * SEQ + tok) * 512 + kvh * 64 + c8 * 8]; }
        { const int d = ch >> 5, rem = ch & 31, half = rem >> 4, c16 = rem & 15; const int tokbase = half ? 128 * qb : (qb == 0 ? 0 : 128 * (qb - 1));
          *(u32x4*)&Vs[d * 272 + half * 128 + c16 * 8] = *(const u32x4*)&vt[(size_t)(kvh * 64 + d) * MT + (size_t)b * SEQ + tokbase + c16 * 8]; }
    }
    __syncthreads();
    const int head = kvh * 4 + (w >> 1), qh = w & 1; const float sink = sinks_l[head] * LOG2E;
    for (int p = 0; p < 2; ++p) {
        const int q0 = 64 * qh + 32 * p, kt0 = q0 >> 4; const size_t rowq = (size_t)b * SEQ + 128 * qb + q0;
        bf16x8 Qf[2][2];
#pragma unroll
        for (int qt = 0; qt < 2; ++qt)
#pragma unroll
            for (int ks = 0; ks < 2; ++ks) Qf[qt][ks] = *(const bf16x8*)&zqs[(rowq + 16 * qt + fr) * 1024 + head * 64 + 32 * ks + 8 * fq];
        f32x4 S[10][2];
#pragma unroll
        for (int i = 0; i < 10; ++i) {
            const bf16x8 K0 = *(const bf16x8*)&Ks[(16 * (kt0 + i) + fr) * 72 + 8 * fq], K1 = *(const bf16x8*)&Ks[(16 * (kt0 + i) + fr) * 72 + 32 + 8 * fq];
#pragma unroll
            for (int qt = 0; qt < 2; ++qt) { S[i][qt] = __builtin_amdgcn_mfma_f32_16x16x32_bf16(K0, Qf[qt][0], (f32x4){0.f, 0.f, 0.f, 0.f}, 0, 0, 0); S[i][qt] = __builtin_amdgcn_mfma_f32_16x16x32_bf16(K1, Qf[qt][1], S[i][qt], 0, 0, 0); }
        }
        float den[2];
#pragma unroll
        for (int qt = 0; qt < 2; ++qt) {
            const int jq = q0 + 16 * qt + fr; float mx = -1e30f;
#pragma unroll
            for (int i = 0; i < 10; ++i)
#pragma unroll
                for (int j = 0; j < 4; ++j) { const int m = 16 * (kt0 + i) + 4 * fq + j; const bool valid = (m > jq) && (m <= jq + 128) && (qb > 0 || m >= 128);
                    const float s = valid ? S[i][qt][j] : -1e30f; S[i][qt][j] = s; mx = fmaxf(mx, s); }
            mx = fmaxf(mx, __shfl_xor(mx, 16)); mx = fmaxf(mx, __shfl_xor(mx, 32)); mx = fmaxf(mx, sink);
            float sum = 0.f;
#pragma unroll
            for (int i = 0; i < 10; ++i)
#pragma unroll
                for (int j = 0; j < 4; ++j) { const float e = fexp2(S[i][qt][j] - mx); S[i][qt][j] = e; sum += e; }
            sum += __shfl_xor(sum, 16); sum += __shfl_xor(sum, 32);
            den[qt] = sum + fexp2(sink - mx);
        }
        f32x4 O[4][2];
#pragma unroll
        for (int dt = 0; dt < 4; ++dt) { O[dt][0] = (f32x4){0.f, 0.f, 0.f, 0.f}; O[dt][1] = (f32x4){0.f, 0.f, 0.f, 0.f}; }
#pragma unroll
        for (int ii = 0; ii < 5; ++ii) {
            bf16x8 Pf[2];
#pragma unroll
            for (int qt = 0; qt < 2; ++qt) { u32x4 pw; pw.x = pk2(S[2 * ii][qt][0], S[2 * ii][qt][1]); pw.y = pk2(S[2 * ii][qt][2], S[2 * ii][qt][3]); pw.z = pk2(S[2 * ii + 1][qt][0], S[2 * ii + 1][qt][1]); pw.w = pk2(S[2 * ii + 1][qt][2], S[2 * ii + 1][qt][3]); Pf[qt] = __builtin_bit_cast(bf16x8, pw); }
#pragma unroll
            for (int dt = 0; dt < 4; ++dt) {
                const s16x4 lo = *(const s16x4*)&Vs[(16 * dt + fr) * 272 + 16 * (kt0 + 2 * ii) + 4 * fq], hi = *(const s16x4*)&Vs[(16 * dt + fr) * 272 + 16 * (kt0 + 2 * ii) + 16 + 4 * fq];
                const bf16x8 Vf = {lo[0], lo[1], lo[2], lo[3], hi[0], hi[1], hi[2], hi[3]};
#pragma unroll
                for (int qt = 0; qt < 2; ++qt) O[dt][qt] = __builtin_amdgcn_mfma_f32_16x16x32_bf16(Vf, Pf[qt], O[dt][qt], 0, 0, 0);
            }
        }
#pragma unroll
        for (int qt = 0; qt < 2; ++qt) { const float inv = 1.f / den[qt];
#pragma unroll
            for (int dt = 0; dt < 4; ++dt) st_bf4(&zo[(rowq + 16 * qt + fr) * 1024 + head * 64 + 16 * dt + 4 * fq], O[dt][qt] * inv); }
    }
    __syncthreads();
}
DI void swa_sample(int b, int head, int lane, const float* cwk_l, const float* cwv_l, const float* newk_l, const float* newv_l, const bf16_t* zqs, bf16_t* zo, const float* sinks_l) {
    const int kvh = head >> 2; const size_t row = (size_t)MPR + b;
    const float qv = bf2f(zqs[row * 1024 + head * 64 + lane]);
    float s[2];
#pragma unroll
    for (int hh = 0; hh < 2; ++hh) { const int j = lane + 64 * hh;
        const float* kp = (j < 127) ? cwk_l + ((size_t)(b * 128 + j + 1) * 4 + kvh) * 64 : newk_l + ((size_t)(b * 128 + 127) * 4 + kvh) * 64;
        float acc = 0.f;
#pragma unroll
        for (int d4 = 0; d4 < 16; ++d4) { const f32x4 kv = *(const f32x4*)(kp + 4 * d4);
            acc += __shfl(qv, 4 * d4) * kv[0] + __shfl(qv, 4 * d4 + 1) * kv[1] + __shfl(qv, 4 * d4 + 2) * kv[2] + __shfl(qv, 4 * d4 + 3) * kv[3]; }
        s[hh] = acc; }
    const float sink = sinks_l[head] * LOG2E;
    const float mx = fmaxf(wave_max(fmaxf(s[0], s[1])), sink);
    const float e0 = fexp2(s[0] - mx), e1 = fexp2(s[1] - mx);
    const float den = wave_sum(e0 + e1) + fexp2(sink - mx);
    float o = 0.f;
#pragma unroll 8
    for (int j = 0; j < 128; ++j) { const float pj = __shfl((j < 64) ? e0 : e1, j & 63);
        const float* vp = (j < 127) ? cwv_l + ((size_t)(b * 128 + j + 1) * 4 + kvh) * 64 : newv_l + ((size_t)(b * 128 + 127) * 4 + kvh) * 64;
        o += pj * vp[lane]; }
    zo[row * 1024 + head * 64 + lane] = f2bf(o / den);
}

DI void mem_item(const int tid, unsigned char* lds, int b, int h, int q8, const bf16_t* mkb_l, const bf16_t* mvt_l, const bf16_t* zxc, bf16_t* zo) {
    const int lane = tid & 63, w = tid >> 6, fr = lane & 15, fq = lane >> 4;
    bf16_t* Km = (bf16_t*)lds;
#pragma unroll
    for (int i = 0; i < 16; ++i) { const int ch = tid + 512 * i, r = ch >> 5, c16 = ch & 31;
        *(u32x4*)&Km[r * 264 + c16 * 8] = *(const u32x4*)&mkb_l[((size_t)b * 256 + r) * 1024 + h * 256 + c16 * 8]; }
    const size_t row = (size_t)b * SEQ + 128 * q8 + 16 * w + fr;
    bf16x8 Qf[8];
#pragma unroll
    for (int ks = 0; ks < 8; ++ks) Qf[ks] = *(const bf16x8*)&zxc[row * 1024 + h * 256 + 32 * ks + 8 * fq];
    __syncthreads();
    f32x4 S[16];
#pragma unroll
    for (int kt = 0; kt < 16; ++kt) { f32x4 acc = {0.f, 0.f, 0.f, 0.f};
#pragma unroll
        for (int ks = 0; ks < 8; ++ks) { const bf16x8 Kf = *(const bf16x8*)&Km[(16 * kt + fr) * 264 + 32 * ks + 8 * fq]; acc = __builtin_amdgcn_mfma_f32_16x16x32_bf16(Kf, Qf[ks], acc, 0, 0, 0); }
        S[kt] = acc; }
    float mx = -1e30f;
#pragma unroll
    for (int kt = 0; kt < 16; ++kt) mx = fmaxf(fmaxf(mx, fmaxf(S[kt][0], S[kt][1])), fmaxf(S[kt][2], S[kt][3]));
    mx = fmaxf(mx, __shfl_xor(mx, 16)); mx = fmaxf(mx, __shfl_xor(mx, 32));
    float sum = 0.f; bf16x8 Pf[8];
#pragma unroll
    for (int ii = 0; ii < 8; ++ii) { f32x4 e0, e1;
#pragma unroll
        for (int j = 0; j < 4; ++j) { e0[j] = fexp2(S[2 * ii][j] - mx); e1[j] = fexp2(S[2 * ii + 1][j] - mx); }
        sum += (e0[0] + e0[1]) + (e0[2] + e0[3]) + (e1[0] + e1[1]) + (e1[2] + e1[3]);
        u32x4 pw; pw.x = pk2(e0[0], e0[1]); pw.y = pk2(e0[2], e0[3]); pw.z = pk2(e1[0], e1[1]); pw.w = pk2(e1[2], e1[3]); Pf[ii] = __builtin_bit_cast(bf16x8, pw); }
    sum += __shfl_xor(sum, 16); sum += __shfl_xor(sum, 32);
    __syncthreads();
    bf16_t* Vm = (bf16_t*)lds;
#pragma unroll
    for (int i = 0; i < 16; ++i) { const int ch = tid + 512 * i, r = ch >> 5, c16 = ch & 31;
        *(u32x4*)&Vm[r * 272 + c16 * 8] = *(const u32x4*)&mvt_l[((size_t)h * 256 + r) * 4096 + (size_t)b * 256 + c16 * 8]; }
    __syncthreads();
    const float inv = 1.f / sum;
#pragma unroll
    for (int dt = 0; dt < 16; ++dt) { f32x4 acc = {0.f, 0.f, 0.f, 0.f};
#pragma unroll
        for (int ii = 0; ii < 8; ++ii) { const s16x4 lo = *(const s16x4*)&Vm[(16 * dt + fr) * 272 + 32 * ii + 4 * fq], hi = *(const s16x4*)&Vm[(16 * dt + fr) * 272 + 32 * ii + 16 + 4 * fq];
            const bf16x8 Vf = {lo[0], lo[1], lo[2], lo[3], hi[0], hi[1], hi[2], hi[3]}; acc = __builtin_amdgcn_mfma_f32_16x16x32_bf16(Vf, Pf[ii], acc, 0, 0, 0); }
        st_bf4(&zo[row * 1024 + h * 256 + 16 * dt + 4 * fq], acc * inv); }
    __syncthreads();
}
DI void mem_sample(const int tid, unsigned char* lds, int b, int h, const float* cmk_l, const float* cmv_l, const bf16_t* zxc, bf16_t* zo) {
    const int lane = tid & 63, w = tid >> 6; const size_t row = (size_t)MPR + b;
    float* sc = (float*)lds;
    float* po = (float*)lds + 256;
    f32x4 q; { const u32x2 qq = *(const u32x2*)&zxc[row * 1024 + h * 256 + 4 * lane]; q[0] = bflo(qq.x); q[1] = bfhi(qq.x); q[2] = bflo(qq.y); q[3] = bfhi(qq.y); }
    const float* kb = cmk_l + (((size_t)b * 256 + 32 * w) * 4 + h) * 256 + 4 * lane;
#pragma unroll 8
    for (int kk = 0; kk < 32; ++kk) { const f32x4 kv = *(const f32x4*)(kb + (size_t)kk * 1024); float d = (q[0] * kv[0] + q[1] * kv[1]) + (q[2] * kv[2] + q[3] * kv[3]); d = wave_sum(d); if (lane == 0) sc[32 * w + kk] = d; }
    __syncthreads();
    const f32x4 sv = *(const f32x4*)&sc[4 * lane];
    const float mx = wave_max(fmaxf(fmaxf(sv[0], sv[1]), fmaxf(sv[2], sv[3])));
    const float sum = wave_sum((fexp2(sv[0] - mx) + fexp2(sv[1] - mx)) + (fexp2(sv[2] - mx) + fexp2(sv[3] - mx)));
    const float inv = 1.f / sum;
    const float* vb = cmv_l + (((size_t)b * 256 + 32 * w) * 4 + h) * 256 + 4 * lane;
    f32x4 o = {0.f, 0.f, 0.f, 0.f};
#pragma unroll 8
    for (int kk = 0; kk < 32; ++kk) { const float p = fexp2(sc[32 * w + kk] - mx) * inv; const f32x4 vv = *(const f32x4*)(vb + (size_t)kk * 1024); o += vv * p; }
    *(f32x4*)&po[w * 256 + 4 * lane] = o;
    __syncthreads();
    if (tid < 256) { float s = 0.f;
#pragma unroll
        for (int ww = 0; ww < 8; ++ww) s += po[ww * 256 + tid];
        zo[row * 1024 + h * 256 + tid] = f2bf(s); }
    __syncthreads();
}

#ifndef REP_PRO
#define REP_PRO 1
#endif
#ifndef REP_SMP
#define REP_SMP 1
#endif
#ifndef REP_LRU
#define REP_LRU 1
#endif
#ifndef REP_SWA
#define REP_SWA 1
#endif
#ifndef REP_MEM
#define REP_MEM 1
#endif
#ifndef REP_GEMM
#define REP_GEMM 1
#endif
#ifndef REP_LN
#define REP_LN 1
#endif
#define REOPQ asm volatile("" : "+s"(ws), "+s"(out), "+s"(G), "+s"(bid), "+s"(l), "+v"(tid));
#define REPG(...) { __VA_ARGS__ } if (REP_GEMM > 1) { REOPQ __VA_ARGS__ }
#define REPL(...) { __VA_ARGS__ } if (REP_LN > 1) { REOPQ __VA_ARGS__ }
#define PHASE_BEGIN if (a.coop || (ph >= a.ph_lo && ph < a.ph_hi)) { unsigned char* ws = a.ws; float* out = a.out; int G = gridDim.x, bid = blockIdx.x, l = l0, tid = wave_s * 64 + (int)__builtin_amdgcn_mbcnt_hi(~0u, __builtin_amdgcn_mbcnt_lo(~0u, 0u)); \
        asm volatile("" : "+s"(ws), "+s"(out), "+s"(G), "+s"(bid), "+s"(l), "+v"(tid)); const int lane = tid & 63, wave = tid >> 6; (void)lane; const int gw = bid * 8 + wave, NGW = G * 8; (void)gw; (void)NGW; (void)out; (void)l;
#define PHASE_END } ++ph; if (a.coop) { int tid_ = wave_s * 64 + (int)__builtin_amdgcn_mbcnt_hi(~0u, __builtin_amdgcn_mbcnt_lo(~0u, 0u)); xcd_barrier((unsigned*)(a.ws + WS_CTL) + 4096, (volatile LAS unsigned*)((LAS unsigned char*)lds + MISC_OFF), tid_); }
#define RB_ ((bf16_t*)(ws + WS_RB))
#define RF_ ((float*)(ws + WS_RF))
#define ZYA_ ((bf16_t*)(ws + WS_ZYA))
#define ZQS_ ((bf16_t*)(ws + WS_ZQS))
#define ZXC_ ((bf16_t*)(ws + WS_ZXC))
#define ZXR_ ((bf16_t*)(ws + WS_ZXR))
#define ZKV_ ((bf16_t*)(ws + WS_ZKV))
#define GT_ ((bf16_t*)(ws + WS_GT))
#define MG_ ((bf16_t*)(ws + WS_MG))
#define VT_ ((bf16_t*)(ws + WS_VT))
#define HID_ ((bf16_t*)(ws + WS_ZYA))
#define MPB_ ((bf16_t*)(ws + WS_MPB))
#define Y_ ((float*)(ws + WS_GT))

template <int l0> DI void layer_phases(const Args& a, unsigned char* lds, const int wave_s, int& ph, cg::grid_group& grid) {
    LAS unsigned char* ldsl = (LAS unsigned char*)lds;
        PHASE_BEGIN
        REPG(
            const bf16_t* WIN = (const bf16_t*)(ws + WS_WIN) + (size_t)l * INC * DM;
            {
            EpiIn E{ws, out, a.in[I_BG] + (size_t)l * 3072, l};
            GridSched S; S.init(NTM, 30, G, bid, 0, 0);
            gemm_phase(tid, ldsl, RB_, WIN, DM, S, E);
            }
            { EpiPlain ET{VT_, MT}; GridSched S2; S2.init(1, NTM, G, (bid + 30) % G, 13, 0);
            gemm_phase(tid, ldsl, WIN, RB_, DM, S2, ET); }
            if (l == 0) {
                for (int l2 = 0; l2 < 2; ++l2) {
                    const bf16_t* WMK = (const bf16_t*)(ws + WS_WMKV) + (size_t)l2 * 2048 * DM;
                    { EpiMem EM{out + O_PMK + (size_t)l2 * 4096 * 1024, out + O_PMV + (size_t)l2 * 4096 * 1024, (bf16_t*)(ws + WS_MKB) + (size_t)l2 * 4096 * DM};
                    GridSched S3; S3.init(16, 8, G, (bid + 159 + 192 * l2) % G, 0, 0);
                    gemm_phase(tid, ldsl, MPB_, WMK, DM, S3, EM); }
                    { EpiPlain EV{(bf16_t*)(ws + WS_MVT) + (size_t)l2 * 4096 * DM, 4096}; GridSched S4; S4.init(4, 16, G, (bid + 31 + 192 * l2) % G, 4, 0);
                    gemm_phase(tid, ldsl, WMK, MPB_, DM, S4, EV); }
                }
            }
        )
        PHASE_END
        PHASE_BEGIN
        {
            const LruP LP{a.in[I_CW] + (size_t)l * 4096, a.in[I_CB] + (size_t)l * 1024, a.in[I_WA] + (size_t)l * 65536, a.in[I_BA] + (size_t)l * 1024, a.in[I_WX] + (size_t)l * 65536, a.in[I_BX] + (size_t)l * 1024, a.in[I_LAM] + (size_t)l * 1024};
            const float* sinks_l = a.in[I_SINK] + l * 16;
#define MIX_SMP(ZA, ZQ, ZC) \
            for (int it = bid; it < 512; it += G) mem_sample(tid, lds, it >> 2, it & 3, a.in[I_CMK] + (size_t)l * 128 * 256 * 1024, a.in[I_CMV] + (size_t)l * 128 * 256 * 1024, ZXC_, ZC); \
            for (int it = gw; it < 2048; it += NGW) lru_sample(it >> 4, it & 15, lane, LP, ZXR_, ZYA_, ZA, a.in[I_SCONV] + (size_t)l * 128 * 3 * 1024, a.in[I_SH] + (size_t)l * 128 * 1024, out + O_SCONV + (size_t)l * 128 * 3 * 1024, out + O_SH + (size_t)l * 128 * 1024); \
            for (int it = gw; it < 2048; it += NGW) swa_sample(it >> 4, it & 15, lane, a.in[I_CWK] + (size_t)l * 128 * 128 * 256, a.in[I_CWV] + (size_t)l * 128 * 128 * 256, out + O_SWK + (size_t)l * 128 * 128 * 256, out + O_SWV + (size_t)l * 128 * 128 * 256, ZQS_, ZQ, sinks_l); \
            for (int i = gw * 64 + lane; i < 2 * 128 * 127 * 64; i += NGW * 64) { const int which = i / (128 * 127 * 64), r = i % (128 * 127 * 64), bb = r / (127 * 64), rr = r % (127 * 64), j = rr >> 6, c4 = (rr & 63) * 4; \
                const float* src = (which ? a.in[I_CWV] : a.in[I_CWK]) + (size_t)l * 128 * 128 * 256 + ((size_t)bb * 128 + j + 1) * 256 + c4; \
                float* dst = out + (which ? O_SWV : O_SWK) + (size_t)l * 128 * 128 * 256 + ((size_t)bb * 128 + j) * 256 + c4; *(f32x4*)dst = *(const f32x4*)src; } \
            __syncthreads();
#define MIX_LRU(ZA) for (int it = bid; it < 256; it += G) lru_item(tid, lds, it >> 4, it & 15, LP, ZXR_, ZYA_, ZA, out + O_PCONV + (size_t)l * 16 * 3 * 1024, out + O_PH + (size_t)l * 16 * 1024);
#define MIX_SWA(ZQ) for (int it = bid; it < 1024; it += G) swa_item(tid, lds, it >> 6, (it >> 4) & 3, it & 15, ZKV_, VT_, ZQS_, ZQ, sinks_l);
#define MIX_MEM(ZC) for (int it = bid; it < 1024; it += G) mem_item(tid, lds, it >> 6, (it >> 4) & 3, it & 15, (const bf16_t*)(ws + WS_MKB) + (size_t)l * 4096 * DM, (const bf16_t*)(ws + WS_MVT) + (size_t)l * 4096 * DM, ZXC_, ZC);
            if (REP_SMP > 1) { MIX_SMP(MG_, MG_, MG_) }
            MIX_SMP(ZYA_, ZQS_, ZXC_)
            if (REP_LRU > 1) { MIX_LRU(MG_) }
            MIX_LRU(ZYA_)
            if (REP_SWA > 1) { MIX_SWA(MG_) }
            MIX_SWA(ZQS_)
            if (REP_MEM > 1) { MIX_MEM(MG_) }
            MIX_MEM(ZXC_)
        }
        PHASE_END
        PHASE_BEGIN
        REPG( EpiBranch E{GT_, MG_}; BranchSched S{G, bid}; gemm_phase(tid, ldsl, ZYA_, (const bf16_t*)(ws + WS_WBR) + (size_t)l * 3072 * DM, DM, S, E); )
        PHASE_END
        PHASE_BEGIN
        REPG( EpiRes E{l == 0 ? a.in[I_XP] : RF_, l == 0 ? a.in[I_XS] : RF_ + (size_t)MPR * 1024, Y_}; GridSched S; S.init(NTM, 4, G, bid, 0, 0); gemm_phase(tid, ldsl, MG_, (const bf16_t*)(ws + WS_WOUT) + (size_t)l * DM * DM, DM, S, E); )
        PHASE_END
        PHASE_BEGIN REPL(ln_phase(Y_, a.in[I_L1G] + l * 1024, a.in[I_L1B] + l * 1024, RF_, RB_, gw, NGW, lane);) PHASE_END
        PHASE_BEGIN
        REPG( EpiGLU E{HID_}; GridSched S; S.init(NTM, 22, G, bid, 0, 0); gemm_phase(tid, ldsl, RB_, (const bf16_t*)(ws + WS_WGU) + (size_t)l * 2 * DFF * DM, DM, S, E); )
        PHASE_END
        PHASE_BEGIN
        REPG( EpiRes E{RF_, RF_ + (size_t)MPR * 1024, Y_}; GridSched S; S.init(NTM, 4, G, bid, 0, 0); gemm_phase(tid, ldsl, HID_, (const bf16_t*)(ws + WS_WDN) + (size_t)l * DM * DFF, DFF, S, E); )
        PHASE_END
        PHASE_BEGIN REPL(ln_phase(Y_, a.in[I_L2G] + l * 1024, a.in[I_L2B] + l * 1024, l == 1 ? out : RF_, RB_, gw, NGW, lane);) PHASE_END
    }

__global__ void __launch_bounds__(512, 2) fwd_kernel(Args a) {
    extern __shared__ __attribute__((aligned(16))) unsigned char lds[];
    cg::grid_group grid = cg::this_grid();
    LAS unsigned char* ldsl = (LAS unsigned char*)lds;
    int ph = 0;
    if (threadIdx.x < 2) ((LAS unsigned*)((LAS unsigned char*)lds + MISC_OFF))[threadIdx.x] = 0u;
    if (a.coop && threadIdx.x == 0) (void)xb_add((unsigned*)(a.ws + WS_CTL) + 4096 + XB_XCNT(xb_xcc_id()), 1u);
    __syncthreads();
    int wave_s = __builtin_amdgcn_readfirstlane((int)threadIdx.x >> 6); asm volatile("" : "+s"(wave_s));
    { const int l0 = 0;
    PHASE_BEGIN
prologue(a, lds, gw, NGW, lane, wave); if (REP_PRO > 1) { __syncthreads(); prologue(a, lds, gw, NGW, lane, wave); }
    } ++ph; if (a.coop) grid.sync();
    }
    layer_phases<0>(a, lds, wave_s, ph, grid);
    layer_phases<1>(a, lds, wave_s, ph, grid);
}

constexpr int N_PHASES = 17;
#ifndef ONE_LAUNCH
#define ONE_LAUNCH 1
#endif
extern "C" void kernel_launch(void* const* d_in, const int* in_sizes, int n_in, void* d_out, int out_size, void* d_ws, size_t ws_size, hipStream_t stream) {
    constexpr int LDS_BYTES = 143360;
    static int grid = 0;
    if (grid == 0) {
        if (n_in != 28 || (size_t)out_size != O_END || ws_size < WS_END) { fprintf(stderr, "kernel_launch: unexpected sizes n_in %d out %d ws %zu (need %zu)\n", n_in, out_size, ws_size, (size_t)WS_END); grid = -1; return; }
        int dev = 0, cus = 0, per_cu = 0;
        (void)hipGetDevice(&dev);
        (void)hipDeviceGetAttribute(&cus, hipDeviceAttributeMultiprocessorCount, dev);
        (void)hipFuncSetAttribute((const void*)fwd_kernel, hipFuncAttributeMaxDynamicSharedMemorySize, LDS_BYTES);
        (void)hipOccupancyMaxActiveBlocksPerMultiprocessor(&per_cu, (const void*)fwd_kernel, 512, LDS_BYTES);
        if (per_cu < 1) per_cu = 1;
        grid = cus * per_cu;
        fprintf(stderr, "kernel_launch: grid %d (cus %d x %d), ws %zu need %zu\n", grid, cus, per_cu, ws_size, (size_t)WS_END);
    }
    if (grid < 0) return;
    (void)hipMemsetAsync((char*)d_ws + WS_CTL, 0, 65536, stream);
    Args a{};
    for (int i = 0; i < 28; ++i) a.in[i] = (const float*)d_in[i];
    a.out = (float*)d_out; a.ws = (unsigned char*)d_ws;
#if ONE_LAUNCH
    a.coop = 1; a.ph_lo = 0; a.ph_hi = N_PHASES;
    void* args[] = {&a};
    hipError_t e = hipLaunchCooperativeKernel((const void*)fwd_kernel, dim3(grid), dim3(512), args, LDS_BYTES, stream);
    if (e != hipSuccess) fprintf(stderr, "cooperative launch failed: %s (grid %d)\n", hipGetErrorString(e), grid);
#else
    a.coop = 0;
    for (int p = 0; p < N_PHASES; ++p) { a.ph_lo = p; a.ph_hi = p + 1; hipLaunchKernelGGL(fwd_kernel, dim3(grid), dim3(512), LDS_BYTES, stream, a); }
#endif
}
```

```cpp
#include <hip/hip_runtime.h>
#include <hip/hip_cooperative_groups.h>
#include <cstdio>
#include <cstdint>
namespace cg = cooperative_groups;

#define DI __device__ __forceinline__
#define LAS __attribute__((address_space(3)))
typedef unsigned short bf16_t;
typedef short bf16x8 __attribute__((ext_vector_type(8)));
typedef short s16x4 __attribute__((ext_vector_type(4)));
typedef float f32x4 __attribute__((ext_vector_type(4)));
typedef float f32x2 __attribute__((ext_vector_type(2)));
typedef unsigned u32x4 __attribute__((ext_vector_type(4)));
typedef unsigned u32x2 __attribute__((ext_vector_type(2)));
typedef __bf16 bf16x2_t __attribute__((ext_vector_type(2)));

DI unsigned pk2(float lo, float hi) { f32x2 v = {lo, hi}; bf16x2_t b = __builtin_convertvector(v, bf16x2_t); return __builtin_bit_cast(unsigned, b); }
DI bf16_t f2bf(float x) { return (bf16_t)(pk2(x, 0.f) & 0xffffu); }
DI float bf2f(bf16_t h) { return __uint_as_float(((unsigned)h) << 16); }
DI float bflo(unsigned w) { return __uint_as_float(w << 16); }
DI float bfhi(unsigned w) { return __uint_as_float(w & 0xffff0000u); }
DI float fexp2(float x) { return __builtin_amdgcn_exp2f(x); }
DI float frcp(float x) { return __builtin_amdgcn_rcpf(x); }
constexpr float LOG2E = 1.4426950408889634f;
DI float sigmoidf_(float x) { return frcp(1.f + fexp2(-x * LOG2E)); }
DI float gelu_tanh(float x) { const float y = 1.5957691216057308f * (x + 0.044715f * x * x * x); return x * sigmoidf_(y); }

constexpr int DM = 1024, NB = 16, SEQ = 2048, NS = 128, MPR = NB * SEQ, MREAL = MPR + NS, MT = 33024, NTM = MT / 256;
constexpr int INC = 7680, DFF = 2816, NMEM = 256;
constexpr float ALPHA = 1.4142135623730951f, LN_EPS = 1e-5f;
constexpr size_t O_YP = 0, O_YS = 33554432, O_PCONV = 33685504, O_PH = 33783808, O_PWK = 33816576, O_PWV = 34865152, O_PMK = 35913728, O_PMV = 44302336,
                 O_SCONV = 52690944, O_SH = 53477376, O_SWK = 53739520, O_SWV = 62128128, O_END = 70516736;
constexpr size_t WS_CTL = 0;
constexpr size_t WS_WIN = 1u << 20;
constexpr size_t WS_WMKV = WS_WIN + 2ull * INC * DM * 2;
constexpr size_t WS_WBR = WS_WMKV + 2ull * 2048 * DM * 2;
constexpr size_t WS_WOUT = WS_WBR + 2ull * 3072 * DM * 2;
constexpr size_t WS_WGU = WS_WOUT + 2ull * DM * DM * 2;
constexpr size_t WS_WDN = WS_WGU + 2ull * 2 * DFF * DM * 2;
constexpr size_t WS_RB = WS_WDN + 2ull * DM * DFF * 2;
constexpr size_t WS_RF = WS_RB + (size_t)MT * DM * 2;
constexpr size_t COLB = (size_t)MT * DM * 2;
constexpr size_t WS_ZYA = WS_RF + (size_t)MT * DM * 4;
constexpr size_t WS_ZQS = WS_ZYA + COLB, WS_ZXC = WS_ZQS + COLB, WS_ZXR = WS_ZXC + COLB, WS_ZKV = WS_ZXR + COLB;
constexpr size_t WS_GT = WS_ZKV + (size_t)MT * 512 * 2;
constexpr size_t WS_MG = WS_GT + (size_t)MT * 3072 * 2;
constexpr size_t WS_VT = WS_MG + COLB;
constexpr size_t WS_MKB = WS_VT + 256ull * MT * 2;
constexpr size_t WS_MVT = WS_MKB + 2ull * 4096 * DM * 2;
constexpr size_t WS_MPB = WS_MVT + 2ull * 4096 * DM * 2;
constexpr size_t WS_END = WS_MPB + 4096ull * DM * 2;
static_assert((size_t)MT * DFF * 2 <= WS_GT - WS_ZYA, "HID overlay");

constexpr int BM = 256, BK = 64, HALF = 128, HTB = HALF * BK * 2, STAGE_BYTES = 8 * HTB;
DI int lds_byte(int r, int c) { const int st = (r >> 4) * 2 + (c >> 5), rr = r & 15, cc = c & 31, ob = rr * 64 + cc * 2; return st * 1024 + (ob ^ (((ob >> 9) & 1) << 5)); }
DI void stage_rc(int b, int& R, int& C) { const int st = b / 1024, sb = b % 1024, swz = sb ^ (((sb >> 9) & 1) << 5); R = (st >> 1) * 16 + swz / 64; C = (st & 1) * 32 + (swz % 64) / 2; }
struct Unit { int pa, pb, pm, pn, aux; };
struct GridSched {
    int nM, nN, nwg, G, c, a0, b0;
    DI void init(int nM_, int nN_, int G_, int c_, int a0_, int b0_) { nM = nM_; nN = nN_; nwg = nM * nN; G = G_; c = c_; a0 = a0_; b0 = b0_; }
    DI bool next(int i, Unit& u) const {
        const long L = (long)i * G + c; if (L >= nwg) return false;
        int wgid = (int)L; { const int q = nwg / 8, r = nwg % 8, xcd = wgid % 8, off = wgid / 8; wgid = (xcd < r ? xcd * (q + 1) : r * (q + 1) + (xcd - r) * q) + off; }
        const int nig = 8 * nN, gid = wgid / nig, fm = gid * 8, gsz = (nM - fm) < 8 ? (nM - fm) : 8;
        u.pm = fm + ((wgid % nig) % gsz); u.pn = (wgid % nig) / gsz; u.pa = a0 + u.pm; u.pb = b0 + u.pn; u.aux = 0; return true;
    }
};
struct BranchSched {
    int G, c;
    DI bool next(int i, Unit& u) const {
        GridSched S; S.init(128, 4, G, c, 0, 0); Unit t; if (!S.next(i / 3, t)) return false;
        const int n = i % 3; u.pm = t.pm; u.pn = t.pn; u.pa = n * NTM + t.pm; u.pb = n * 4 + t.pn; u.aux = n; return true;
    }
};

template <class Epi, class Sched>
DI void gemm_phase(const int tid, LAS unsigned char* lds, const bf16_t* gA, const bf16_t* gB, const int K, const Sched& S, const Epi& E) {
    const int wid = __builtin_amdgcn_readfirstlane(tid >> 6), lane = tid & 63, wr = wid >> 2, wc = wid & 3, fr = lane & 15, fq = lane >> 4;
    const int nt = K / BK;
    unsigned voff[2];
#pragma unroll
    for (int i = 0; i < 2; ++i) { int R, C; stage_rc(tid * 16 + i * 8192, R, C); voff[i] = (unsigned)(R * K + C) * 2u; }
    const size_t kstep = (size_t)(BK * 2);
    const size_t hstep = (size_t)HALF * K * 2;
    const size_t tstep = 2 * hstep;
    const unsigned ldsw = (unsigned)wid * 1024u;
    const int aoff = lds_byte(wr * 64 + fr, fq * 8), boff = lds_byte(wc * 32 + fr, fq * 8);
#define PG8_SA(b, h) (((b) * 2 + (h)) * HTB)
#define PG8_SB(b, h) ((4 + (b) * 2 + (h)) * HTB)
#define PG8_STAGE(bufoff, gbase) do { _Pragma("unroll") for (int _i = 0; _i < 2; ++_i) \
        __builtin_amdgcn_global_load_lds((const unsigned*)((const char*)(gbase) + voff[_i]), (LAS unsigned*)(lds + (bufoff) + ldsw + _i * 8192), 16, 0, 0); } while (0)
#define PG8_LDA(dst, b, h) do { _Pragma("unroll") for (int m = 0; m < 4; ++m) _Pragma("unroll") for (int k = 0; k < 2; ++k) dst[m][k] = *(const LAS bf16x8*)(lds + PG8_SA(b, h) + aoff + m * 2048 + k * 1024); } while (0)
#define PG8_LDB(dst, b, h) do { _Pragma("unroll") for (int n = 0; n < 2; ++n) _Pragma("unroll") for (int k = 0; k < 2; ++k) dst[n][k] = *(const LAS bf16x8*)(lds + PG8_SB(b, h) + boff + n * 2048 + k * 1024); } while (0)
#define PG8_MMA(ai, bj, At, Bt) do { __builtin_amdgcn_s_setprio(1); _Pragma("unroll") for (int m = 0; m < 4; ++m) _Pragma("unroll") for (int n = 0; n < 2; ++n) _Pragma("unroll") for (int k = 0; k < 2; ++k) \
        acc[ai][bj][m][n] = __builtin_amdgcn_mfma_f32_16x16x32_bf16(Bt[n][k], At[m][k], acc[ai][bj][m][n], 0, 0, 0); __builtin_amdgcn_s_setprio(0); } while (0)
#define PG8_WAIT_V(n) asm volatile("s_waitcnt vmcnt(" #n ")" ::: "memory")
#define PG8_WAIT_L(n) asm volatile("s_waitcnt lgkmcnt(" #n ")" ::: "memory")
#define PG8_BAR __builtin_amdgcn_s_barrier()
#define PG8_SCHED __builtin_amdgcn_sched_barrier(0)
    Unit cur, nxt; int ui = 0;
    if (!S.next(0, cur)) return;
    f32x4 acc[2][2][4][2];
#pragma unroll
    for (int a = 0; a < 2; ++a)
#pragma unroll
        for (int b = 0; b < 2; ++b)
#pragma unroll
            for (int m = 0; m < 4; ++m)
#pragma unroll
                for (int n = 0; n < 2; ++n) acc[a][b][m][n] = (f32x4){0.f, 0.f, 0.f, 0.f};
    bf16x8 At[4][2], B0[2][2], B1[2][2];
    const char* cA = (const char*)gA + (size_t)cur.pa * tstep; const char* cB = (const char*)gB + (size_t)cur.pb * tstep;
    PG8_STAGE(PG8_SB(0, 0), cB); PG8_STAGE(PG8_SB(0, 1), cB + hstep); PG8_STAGE(PG8_SA(0, 0), cA); PG8_STAGE(PG8_SA(0, 1), cA + hstep);
    if (wr == 1) PG8_BAR;
    PG8_WAIT_V(2); PG8_BAR;
    PG8_STAGE(PG8_SB(1, 0), cB + kstep); PG8_STAGE(PG8_SA(1, 0), cA + kstep); PG8_STAGE(PG8_SB(1, 1), cB + hstep + kstep);
    PG8_WAIT_V(6); PG8_BAR;
    for (;;) {
        const bool has_next = S.next(ui + 1, nxt);
        const char* nA = has_next ? (const char*)gA + (size_t)nxt.pa * tstep : cA; const char* nB = has_next ? (const char*)gB + (size_t)nxt.pb * tstep : cB;
        for (int t = 0; t < nt; t += 2) {
            const bool last = (t == nt - 2);
            const char* a1 = cA + (size_t)(t + 1) * kstep;
            const char* a2 = last ? nA : cA + (size_t)(t + 2) * kstep; const char* b2 = last ? nB : cB + (size_t)(t + 2) * kstep;
            const char* a3 = a2 + kstep; const char* b3 = b2 + kstep;
            PG8_LDB(B0, 0, 0); PG8_LDB(B1, 0, 1); PG8_SCHED; PG8_LDA(At, 0, 0); PG8_STAGE(PG8_SA(1, 1), a1 + hstep);
            PG8_WAIT_V(8); PG8_WAIT_L(0); PG8_BAR; PG8_MMA(0, 0, At, B0); PG8_MMA(0, 1, At, B1); PG8_BAR; PG8_SCHED;
            PG8_LDA(At, 0, 1); PG8_STAGE(PG8_SB(0, 0), b2); PG8_STAGE(PG8_SB(0, 1), b2 + hstep); PG8_STAGE(PG8_SA(0, 0), a2);
            PG8_WAIT_V(8); PG8_WAIT_L(0); PG8_BAR; PG8_MMA(1, 0, At, B0); PG8_MMA(1, 1, At, B1); PG8_BAR; PG8_SCHED;
            PG8_LDB(B0, 1, 0); PG8_LDB(B1, 1, 1); PG8_SCHED; PG8_LDA(At, 1, 0); PG8_STAGE(PG8_SA(0, 1), a2 + hstep);
            PG8_WAIT_V(8); PG8_WAIT_L(0); PG8_BAR; PG8_MMA(0, 0, At, B0); PG8_MMA(0, 1, At, B1); PG8_BAR; PG8_SCHED;
            PG8_LDA(At, 1, 1); PG8_STAGE(PG8_SB(1, 0), b3); PG8_STAGE(PG8_SB(1, 1), b3 + hstep); PG8_STAGE(PG8_SA(1, 0), a3);
            PG8_WAIT_V(8); PG8_WAIT_L(0); PG8_BAR; PG8_MMA(1, 0, At, B0); PG8_MMA(1, 1, At, B1); PG8_BAR; PG8_SCHED;
        }
        if (wr == 0) PG8_BAR;
        E(acc, cur, wr, wc, fr, fq);
        if (!has_next) break;
#pragma unroll
        for (int a = 0; a < 2; ++a)
#pragma unroll
            for (int b = 0; b < 2; ++b)
#pragma unroll
                for (int m = 0; m < 4; ++m)
#pragma unroll
                    for (int n = 0; n < 2; ++n) acc[a][b][m][n] = (f32x4){0.f, 0.f, 0.f, 0.f};
        cur = nxt; cA = nA; cB = nB; ++ui;
        if (wr == 1) PG8_BAR;
    }
    PG8_WAIT_V(0);
    PG8_BAR;
#undef PG8_SA
#undef PG8_SB
#undef PG8_STAGE
#undef PG8_LDA
#undef PG8_LDB
#undef PG8_MMA
#undef PG8_WAIT_V
#undef PG8_WAIT_L
#undef PG8_BAR
#undef PG8_SCHED
}
#define EPI_LOOP(BODY) _Pragma("unroll") for (int ai = 0; ai < 2; ++ai) _Pragma("unroll") for (int m = 0; m < 4; ++m) { const int row = u.pm * 256 + ai * 128 + wr * 64 + m * 16 + fr; \
    _Pragma("unroll") for (int bj = 0; bj < 2; ++bj) _Pragma("unroll") for (int n = 0; n < 2; ++n) { const int col = bj * 128 + wc * 32 + n * 16 + 4 * fq; const f32x4 v = acc[ai][bj][m][n]; BODY } }
DI void st_bf4(bf16_t* p, f32x4 v) { u32x2 w; w.x = pk2(v[0], v[1]); w.y = pk2(v[2], v[3]); *(u32x2*)p = w; }

struct EpiPlain { bf16_t* O; int ldc;
    DI void operator()(const f32x4 (&acc)[2][2][4][2], const Unit& u, int wr, int wc, int fr, int fq) const { EPI_LOOP( st_bf4(O + (size_t)row * ldc + u.pn * 256 + col, v); ) } };
struct EpiMem { float* pk; float* pv; bf16_t* mkb;
    DI void operator()(const f32x4 (&acc)[2][2][4][2], const Unit& u, int wr, int wc, int fr, int fq) const {
        const bool isk = u.pn < 4; float* dst = isk ? pk : pv; const int c0 = (u.pn & 3) * 256;
        EPI_LOOP( *(f32x4*)(dst + (size_t)row * 1024 + c0 + col) = v; if (isk) st_bf4(mkb + (size_t)row * 1024 + c0 + col, v); ) } };
struct EpiIn { unsigned char* ws; float* out; const float* bg; int l;
    DI void apply(const int row, const int pn, const int col, const f32x4 v) const {
        size_t boff; int ldc = 1024, c0, mode; float sc = 1.f;
        if (pn < 4) { boff = WS_ZXR; c0 = pn * 256; mode = 0; }
        else if (pn < 8) { boff = WS_ZYA; c0 = (pn - 4) * 256; mode = 1; }
        else if (pn < 12) { boff = WS_ZQS; c0 = (pn - 8) * 256; mode = 2; sc = 0.125f * LOG2E; }
        else if (pn < 14) { boff = WS_ZKV; ldc = 512; c0 = (pn - 12) * 256; mode = 4; }
        else if (pn < 18) { boff = WS_ZXC; c0 = (pn - 14) * 256; mode = 2; sc = 0.0625f * LOG2E; }
        else { boff = WS_GT; ldc = 3072; c0 = (pn - 18) * 256; mode = 3; }
        bf16_t* base = (bf16_t*)(ws + boff);
        f32x4 o = v;
        if (mode == 1) { o[0] = gelu_tanh(v[0]); o[1] = gelu_tanh(v[1]); o[2] = gelu_tanh(v[2]); o[3] = gelu_tanh(v[3]); }
        else if (mode == 2) { o = v * sc; }
        else if (mode == 3) { const f32x4 bb = *(const f32x4*)(bg + c0 + col); o[0] = sigmoidf_(v[0] + bb[0]); o[1] = sigmoidf_(v[1] + bb[1]); o[2] = sigmoidf_(v[2] + bb[2]); o[3] = sigmoidf_(v[3] + bb[3]); }
        else if (mode == 4) {
            float* pw = out + ((pn == 12) ? O_PWK : O_PWV) + (size_t)l * 16 * 128 * 256; float* sw = out + ((pn == 12) ? O_SWK : O_SWV) + (size_t)l * 128 * 128 * 256;
            if (row < MPR) { const int t = row & (SEQ - 1); if (t >= SEQ - 128) *(f32x4*)(pw + ((size_t)((row >> 11) * 128 + (t - (SEQ - 128))) * 256 + col)) = v; }
            else if (row < MREAL) { *(f32x4*)(sw + ((size_t)((row - MPR) * 128 + 127) * 256 + col)) = v; }
        }
        st_bf4(base + (size_t)row * ldc + c0 + col, o);
    }
    DI void operator()(const f32x4 (&acc)[2][2][4][2], const Unit& u, int wr, int wc, int fr, int fq) const { EPI_LOOP( apply(row, u.pn, col, v); ) } };
struct EpiBranch { const bf16_t* gt; bf16_t* mg;
    DI void operator()(const f32x4 (&acc)[2][2][4][2], const Unit& u, int wr, int wc, int fr, int fq) const {
        const int nb = u.aux, c0 = u.pn * 256;
        EPI_LOOP(
            const u32x2 g = *(const u32x2*)(gt + (size_t)row * 3072 + nb * 1024 + c0 + col);
            f32x4 o; o[0] = bflo(g.x) * v[0]; o[1] = bfhi(g.x) * v[1]; o[2] = bflo(g.y) * v[2]; o[3] = bfhi(g.y) * v[3];
            bf16_t* p = mg + (size_t)row * 1024 + c0 + col;
            if (nb > 0) { const u32x2 q = *(const u32x2*)p; o[0] += bflo(q.x); o[1] += bfhi(q.x); o[2] += bflo(q.y); o[3] += bfhi(q.y); }
            st_bf4(p, o); ) } };
struct EpiRes { const float* resP; const float* resS; float* Y;
    DI void apply(const int row, const int pn, const int col, const f32x4 v) const {
        if (row < MREAL) { const float* rp = (row < MPR) ? resP + (size_t)row * 1024 : resS + (size_t)(row - MPR) * 1024;
            const f32x4 r = *(const f32x4*)(rp + pn * 256 + col); *(f32x4*)(Y + (size_t)row * 1024 + pn * 256 + col) = r * ALPHA + v; } }
    DI void operator()(const f32x4 (&acc)[2][2][4][2], const Unit& u, int wr, int wc, int fr, int fq) const { EPI_LOOP( apply(row, u.pn, col, v); ) } };
struct EpiGLU { bf16_t* hid;
    DI void apply(const int row, const int pn, const int col, const f32x4 g, const f32x4 up) const {
        f32x4 o; o[0] = g[0] * sigmoidf_(g[0]) * up[0]; o[1] = g[1] * sigmoidf_(g[1]) * up[1]; o[2] = g[2] * sigmoidf_(g[2]) * up[2]; o[3] = g[3] * sigmoidf_(g[3]) * up[3];
        st_bf4(hid + (size_t)row * DFF + pn * 128 + col, o); }
    DI void operator()(const f32x4 (&acc)[2][2][4][2], const Unit& u, int wr, int wc, int fr, int fq) const {
#pragma unroll
        for (int ai = 0; ai < 2; ++ai)
#pragma unroll
            for (int m = 0; m < 4; ++m) { const int row = u.pm * 256 + ai * 128 + wr * 64 + m * 16 + fr;
#pragma unroll
                for (int n = 0; n < 2; ++n) apply(row, u.pn, wc * 32 + n * 16 + 4 * fq, acc[ai][0][m][n], acc[ai][1][m][n]); } } };

template <int J, int U> DI void skinny_mm(const bf16_t* arow, const bf16_t* b0, const bf16_t* b1, const int K, f32x4 (&acc)[J]) {
    for (int k0 = 0; k0 < K; k0 += 32 * U) {
        bf16x8 af[U], bf[J][U];
#pragma unroll
        for (int u = 0; u < U; ++u) { af[u] = *(const bf16x8*)(arow + k0 + 32 * u); bf[0][u] = *(const bf16x8*)(b0 + k0 + 32 * u); if (J > 1) bf[J - 1][u] = *(const bf16x8*)(b1 + k0 + 32 * u); }
#pragma unroll
        for (int u = 0; u < U; ++u)
#pragma unroll
            for (int j = 0; j < J; ++j) acc[j] = __builtin_amdgcn_mfma_f32_16x16x32_bf16(bf[j][u], af[u], acc[j], 0, 0, 0);
    }
}
#ifndef REP_SK
#define REP_SK 1
#endif
#define SKINNY_UNITS(NWU) for (int rep_ = 0; rep_ < REP_SK; ++rep_) for (int wu = wave * G + bid; wu < (NWU); wu += 8 * G)

DI float wave_sum(float v) {
#pragma unroll
    for (int o = 1; o < 64; o <<= 1) v += __shfl_xor(v, o);
    return v;
}
DI float wave_max(float v) {
#pragma unroll
    for (int o = 1; o < 64; o <<= 1) v = fmaxf(v, __shfl_xor(v, o));
    return v;
}
DI void transpose_item(const float* W, int ldw, int src_col0, int k0, bf16_t* WT, int ldk, int dst_row0, float* scr, int lane) {
#pragma unroll 8
    for (int i = 0; i < 32; ++i) { const int kk = 2 * i + (lane >> 5); scr[kk * 33 + (lane & 31)] = W[(size_t)(k0 + kk) * ldw + src_col0 + (lane & 31)]; }
    asm volatile("s_waitcnt lgkmcnt(0)" ::: "memory");
    const int c = lane & 7;
#pragma unroll
    for (int j = 0; j < 4; ++j) { const int n = (lane >> 3) + 8 * j; const float* s = scr + (8 * c) * 33 + n;
        u32x4 o; o.x = pk2(s[0 * 33], s[1 * 33]); o.y = pk2(s[2 * 33], s[3 * 33]); o.z = pk2(s[4 * 33], s[5 * 33]); o.w = pk2(s[6 * 33], s[7 * 33]);
        *(u32x4*)(WT + (size_t)(dst_row0 + n) * ldk + k0 + 8 * c) = o; }
    asm volatile("s_waitcnt lgkmcnt(0)" ::: "memory");
}


#define XB_TMO      128
#define XB_XCNT(j)  (256  + 64 * (j))
#define XB_XSUB(j)  (1280 + 64 * (j))
#define XB_XGEN(j)  (2304 + 64 * (j))
#define XB_TOP      3328
#define XB_TOPGEN   3392
#define XCD_BAR_WORDS 3456
#define XB_SPIN_CAP (1u << 22)
DI unsigned xb_ld(unsigned* p)              { return __hip_atomic_load(p, __ATOMIC_RELAXED, __HIP_MEMORY_SCOPE_AGENT); }
DI unsigned xb_add(unsigned* p, unsigned v) { return __hip_atomic_fetch_add(p, v, __ATOMIC_RELAXED, __HIP_MEMORY_SCOPE_AGENT); }
DI unsigned xb_xcc_id() { return (unsigned)__builtin_amdgcn_s_getreg((3 << 11) | 20) & 0xFu; }
#define XB_SPIN(cond, bar) do { unsigned _sp = 0; while (cond) { __builtin_amdgcn_s_sleep(1); \
    if ((++_sp & 255u) == 0u) { if (xb_ld(&(bar)[XB_TMO])) break; if (_sp > XB_SPIN_CAP) { atomicAdd(&(bar)[XB_TMO], 1u); break; } } } } while (0)
DI void xcd_barrier_complete(unsigned* bar, unsigned x, unsigned& nloc, unsigned& nx) {
    const unsigned G = gridDim.x;
    unsigned sum, cnt, mine, sp = 0u;
    for (;;) {
        sum = 0u; cnt = 0u; mine = 0u;
#pragma unroll
        for (unsigned j = 0; j < 16; ++j) { const unsigned c = xb_ld(&bar[XB_XCNT(j)]); sum += c; cnt += (c > 0u) ? 1u : 0u; mine = (j == x) ? c : mine; }
        if (sum == G) break;
        __builtin_amdgcn_s_sleep(1);
        if ((++sp & 255u) == 0u) { if (xb_ld(&bar[XB_TMO])) break; if (sp > XB_SPIN_CAP) { atomicAdd(&bar[XB_TMO], 1u); break; } }
    }
    nloc = mine > 0u ? mine : 1u; nx = cnt > 0u ? cnt : 1u;
}
DI void xcd_barrier(unsigned* bar, volatile LAS unsigned* st, const int tid) {
    asm volatile("s_waitcnt vmcnt(0)" ::: "memory");
    __syncthreads();
    if (tid == 0) {
        __builtin_amdgcn_s_waitcnt(0);
        const unsigned x = xb_xcc_id();
        unsigned nloc = st[0], nx = st[1];
        if (nloc == 0u) { xcd_barrier_complete(bar, x, nloc, nx); st[0] = nloc; st[1] = nx; }
        const unsigned old = xb_add(&bar[XB_XSUB(x)], 1u);
        const unsigned gen = old / nloc;
        if (old + 1u == (gen + 1u) * nloc) {
            __builtin_amdgcn_fence(__ATOMIC_RELEASE, "agent");
            asm volatile("s_waitcnt vmcnt(0)" ::: "memory");
            const unsigned og = xb_add(&bar[XB_TOP], 1u);
            const unsigned tg = og / nx;
            if (og + 1u == (tg + 1u) * nx) xb_add(&bar[XB_TOPGEN], 1u);
            else XB_SPIN(xb_ld(&bar[XB_TOPGEN]) == tg, bar);
            __builtin_amdgcn_fence(__ATOMIC_ACQUIRE, "agent");
            xb_add(&bar[XB_XGEN(x)], 1u);
            asm volatile("s_waitcnt vmcnt(0)" ::: "memory");
        } else {
            XB_SPIN(xb_ld(&bar[XB_XGEN(x)]) == gen, bar);
            __builtin_amdgcn_fence(__ATOMIC_ACQUIRE, "agent");
            asm volatile("s_waitcnt vmcnt(0)" ::: "memory");
        }
    }
    __syncthreads();
}
constexpr int MISC_OFF = 141312;

struct Args { const float* in[28]; float* out; unsigned char* ws; int ph_lo, ph_hi, coop, pad; };
enum { I_XP = 0, I_XS, I_SCONV, I_SH, I_CWK, I_CWV, I_CMK, I_CMV, I_MEMP, I_WMKV, I_WIN, I_BG, I_CW, I_CB, I_WA, I_BA, I_WX, I_BX, I_LAM, I_SINK, I_WBR, I_WOUT, I_L1G, I_L1B, I_WGU, I_WDN, I_L2G, I_L2B };

DI void prologue(const Args& a, unsigned char* lds, int gw, int NGW, int lane, int wave) {
    unsigned char* ws = a.ws;
    float* scr = (float*)(lds + wave * 16384);
    constexpr int N_IN = 16 * 240, N_MK = 16 * 64, N_BR = 3 * 16 * 32, N_OUT = 16 * 32, N_GU = 16 * 176, N_DN = 44 * 32, N_L = N_IN + N_MK + N_BR + N_OUT + N_GU + N_DN;
    for (int it = gw; it < 2 * N_L; it += NGW) {
        const int l = it / N_L; int r = it % N_L;
        if (r < N_IN) { const int kb = r / 240, nb = r % 240; transpose_item(a.in[I_WIN] + (size_t)l * DM * INC, INC, 32 * nb, 64 * kb, (bf16_t*)(ws + WS_WIN) + (size_t)l * INC * DM, DM, 32 * nb, scr, lane); continue; } r -= N_IN;
        if (r < N_MK) { const int kb = r / 64, nb = r % 64; transpose_item(a.in[I_WMKV] + (size_t)l * DM * 2048, 2048, 32 * nb, 64 * kb, (bf16_t*)(ws + WS_WMKV) + (size_t)l * 2048 * DM, DM, 32 * nb, scr, lane); continue; } r -= N_MK;
        if (r < N_BR) { const int n = r / 512, rr = r % 512, kb = rr / 32, nb = rr % 32; transpose_item(a.in[I_WBR] + (size_t)(l * 3 + n) * DM * DM, DM, 32 * nb, 64 * kb, (bf16_t*)(ws + WS_WBR) + (size_t)l * 3072 * DM, DM, n * 1024 + 32 * nb, scr, lane); continue; } r -= N_BR;
        if (r < N_OUT) { const int kb = r / 32, nb = r % 32; transpose_item(a.in[I_WOUT] + (size_t)l * DM * DM, DM, 32 * nb, 64 * kb, (bf16_t*)(ws + WS_WOUT) + (size_t)l * DM * DM, DM, 32 * nb, scr, lane); continue; } r -= N_OUT;
        if (r < N_GU) { const int kb = r / 176, nb = r % 176, dr = 32 * nb, pn = dr >> 8, half = (dr >> 7) & 1, cc = dr & 127;
            transpose_item(a.in[I_WGU] + (size_t)l * DM * 2 * DFF, 2 * DFF, half * DFF + 128 * pn + cc, 64 * kb, (bf16_t*)(ws + WS_WGU) + (size_t)l * 2 * DFF * DM, DM, dr, scr, lane); continue; } r -= N_GU;
        { const int kb = r / 32, nb = r % 32; transpose_item(a.in[I_WDN] + (size_t)l * DFF * DM, DM, 32 * nb, 64 * kb, (bf16_t*)(ws + WS_WDN) + (size_t)l * DM * DFF, DFF, 32 * nb, scr, lane); }
    }
    const int gt_ = gw * 64 + lane, GT_ = NGW * 64;
    bf16_t* rb = (bf16_t*)(ws + WS_RB);
    for (int i = gt_; i < MT * 128; i += GT_) { const int row = i >> 7, c8 = (i & 127) * 8; u32x4 o = {0u, 0u, 0u, 0u};
        if (row < MREAL) { const float* s = (row < MPR ? a.in[I_XP] + (size_t)row * 1024 : a.in[I_XS] + (size_t)(row - MPR) * 1024) + c8; const f32x4 v0 = *(const f32x4*)s, v1 = *(const f32x4*)(s + 4);
            o.x = pk2(v0[0], v0[1]); o.y = pk2(v0[2], v0[3]); o.z = pk2(v1[0], v1[1]); o.w = pk2(v1[2], v1[3]); }
        *(u32x4*)(rb + (size_t)row * 1024 + c8) = o; }
    bf16_t* mpb = (bf16_t*)(ws + WS_MPB);
    for (int i = gt_; i < 4096 * 128; i += GT_) { const float* s = a.in[I_MEMP] + (size_t)i * 8; const f32x4 v0 = *(const f32x4*)s, v1 = *(const f32x4*)(s + 4); u32x4 o;
        o.x = pk2(v0[0], v0[1]); o.y = pk2(v0[2], v0[3]); o.z = pk2(v1[0], v1[1]); o.w = pk2(v1[2], v1[3]); *(u32x4*)(mpb + (size_t)i * 8) = o; }
}

DI void ln_phase(const float* Y, const float* g, const float* bt, float* outF, bf16_t* outB, int gw, int NGW, int lane) {
    f32x4 gv[4], bv[4];
#pragma unroll
    for (int j = 0; j < 4; ++j) { gv[j] = *(const f32x4*)(g + 4 * lane + 256 * j); bv[j] = *(const f32x4*)(bt + 4 * lane + 256 * j); }
    for (int row = gw; row < MREAL; row += NGW) {
        const float* y = Y + (size_t)row * 1024 + 4 * lane; f32x4 v[4]; float s = 0.f;
#pragma unroll
        for (int j = 0; j < 4; ++j) { v[j] = *(const f32x4*)(y + 256 * j); s += (v[j][0] + v[j][1]) + (v[j][2] + v[j][3]); }
        const float mean = wave_sum(s) * (1.f / 1024.f); float s2 = 0.f;
#pragma unroll
        for (int j = 0; j < 4; ++j) { v[j] = v[j] - mean; s2 += (v[j][0] * v[j][0] + v[j][1] * v[j][1]) + (v[j][2] * v[j][2] + v[j][3] * v[j][3]); }
        const float rstd = 1.f / sqrtf(wave_sum(s2) * (1.f / 1024.f) + LN_EPS);
#pragma unroll
        for (int j = 0; j < 4; ++j) { const f32x4 o = v[j] * rstd * gv[j] + bv[j]; *(f32x4*)(outF + (size_t)row * 1024 + 4 * lane + 256 * j) = o; st_bf4(outB + (size_t)row * 1024 + 4 * lane + 256 * j, o); }
    }
}

struct LruP { const float *cw, *cb, *wa, *ba, *wx, *bx, *lam; };
DI void lru_gate(float rpre, float ipre, float xc, float nsp, float& a, float& uu) {
    const float r = sigmoidf_(rpre), ig = sigmoidf_(ipre);
    a = fexp2(nsp * r);
    uu = __builtin_amdgcn_sqrtf(fmaxf(1.f - a * a, 0.f)) * (ig * xc);
}
DI void lru_item(const int tid, unsigned char* lds, int b, int blk, const LruP& P, const bf16_t* zxr, const bf16_t* zya, bf16_t* zo, float* pconv_l, float* ph_l) {
    const int lane = tid & 63, w = tid >> 6, fr = lane & 15, fq = lane >> 4, c = blk * 64 + lane;
    bf16_t* xcs = (bf16_t*)lds + w * 16 * 72;
    float* rp = (float*)(lds + 18432) + w * 16 * 68;
    float* ip = (float*)(lds + 18432 + 34816) + w * 16 * 68;
    float* tot = (float*)(lds + 18432 + 2 * 34816);
    const float cw0 = P.cw[c], cw1 = P.cw[1024 + c], cw2 = P.cw[2048 + c], cw3 = P.cw[3072 + c], cb = P.cb[c], ba = P.ba[c], bx = P.bx[c];
    const float nsp = -8.f * LOG2E * log1pf(__expf(-P.lam[c]));
    bf16x8 Ba[4][2], Bx[4][2];
#pragma unroll
    for (int nt = 0; nt < 4; ++nt)
#pragma unroll
        for (int ks = 0; ks < 2; ++ks)
#pragma unroll
            for (int e = 0; e < 8; ++e) { const int i = 32 * ks + 8 * fq + e, j = 16 * nt + fr;
                Ba[nt][ks][e] = (short)f2bf(P.wa[((size_t)blk * 64 + i) * 64 + j]); Bx[nt][ks][e] = (short)f2bf(P.wx[((size_t)blk * 64 + i) * 64 + j]); }
    float carry = 0.f; int par = 0;
    unsigned short xn[19], gyn[16];
    { const int t0 = 16 * w; const size_t rowbase = (size_t)b * SEQ + t0;
#pragma unroll
      for (int k = 0; k < 19; ++k) xn[k] = (t0 + k - 3 >= 0) ? zxr[(rowbase + k - 3) * 1024 + c] : (unsigned short)0;
#pragma unroll
      for (int t = 0; t < 16; ++t) gyn[t] = zya[(rowbase + t) * 1024 + c]; }
    for (int chunk = 0; chunk < 16; ++chunk) {
        const int t0 = chunk * 128 + 16 * w; const size_t rowbase = (size_t)b * SEQ + t0;
        float x[19], gy[16];
#pragma unroll
        for (int k = 0; k < 19; ++k) x[k] = bf2f(xn[k]);
#pragma unroll
        for (int t = 0; t < 16; ++t) gy[t] = bf2f(gyn[t]);
        if (chunk < 15) {
#pragma unroll
            for (int k = 0; k < 19; ++k) xn[k] = zxr[(rowbase + 128 + k - 3) * 1024 + c];
#pragma unroll
            for (int t = 0; t < 16; ++t) gyn[t] = zya[(rowbase + 128 + t) * 1024 + c];
        }
        float xc[16];
#pragma unroll
        for (int t = 0; t < 16; ++t) { xc[t] = cb + cw0 * x[t] + cw1 * x[t + 1] + cw2 * x[t + 2] + cw3 * x[t + 3]; xcs[t * 72 + lane] = f2bf(xc[t]); }
        const bf16x8 A0 = *(const bf16x8*)&xcs[fr * 72 + 8 * fq], A1 = *(const bf16x8*)&xcs[fr * 72 + 32 + 8 * fq];
#pragma unroll
        for (int nt = 0; nt < 4; ++nt) {
            f32x4 r = __builtin_amdgcn_mfma_f32_16x16x32_bf16(A0, Ba[nt][0], (f32x4){0.f, 0.f, 0.f, 0.f}, 0, 0, 0); r = __builtin_amdgcn_mfma_f32_16x16x32_bf16(A1, Ba[nt][1], r, 0, 0, 0);
            f32x4 q = __builtin_amdgcn_mfma_f32_16x16x32_bf16(A0, Bx[nt][0], (f32x4){0.f, 0.f, 0.f, 0.f}, 0, 0, 0); q = __builtin_amdgcn_mfma_f32_16x16x32_bf16(A1, Bx[nt][1], q, 0, 0, 0);
#pragma unroll
            for (int j = 0; j < 4; ++j) { rp[(4 * fq + j) * 68 + 16 * nt + fr] = r[j]; ip[(4 * fq + j) * 68 + 16 * nt + fr] = q[j]; }
        }
        float Hs[16], Ps[16]; float Hc = 0.f, Pc = 1.f;
#pragma unroll
        for (int t = 0; t < 16; ++t) { float av, uv; lru_gate(rp[t * 68 + lane] + ba, ip[t * 68 + lane] + bx, xc[t], nsp, av, uv); Hc = av * Hc + uv; Pc = av * Pc; Hs[t] = Hc; Ps[t] = Pc; }
        tot[((par * 8 + w) * 64 + lane) * 2 + 0] = Pc; tot[((par * 8 + w) * 64 + lane) * 2 + 1] = Hc;
        __syncthreads();
        float h = carry, hin = 0.f;
#pragma unroll
        for (int w2 = 0; w2 < 8; ++w2) { const float p = tot[((par * 8 + w2) * 64 + lane) * 2 + 0], hh = tot[((par * 8 + w2) * 64 + lane) * 2 + 1]; if (w2 == w) hin = h; h = p * h + hh; }
        carry = h; par ^= 1;
#pragma unroll
        for (int t = 0; t < 16; ++t) zo[(rowbase + t) * 1024 + c] = f2bf((Hs[t] + Ps[t] * hin) * gy[t]);
        if (chunk == 15 && w == 7) {
#pragma unroll
            for (int k = 0; k < 3; ++k) pconv_l[((size_t)b * 3 + k) * 1024 + c] = x[16 + k];
        }
    }
    if (w == 0) ph_l[(size_t)b * 1024 + c] = carry;
    __syncthreads();
}
DI void lru_sample(int b, int blk, int lane, const LruP& P, const bf16_t* zxr, const bf16_t* zya, bf16_t* zo, const float* sconv_l, const float* sh_l, float* oconv_l, float* oh_l) {
    const int c = blk * 64 + lane; const size_t row = (size_t)MPR + b;
    const float xn = bf2f(zxr[row * 1024 + c]);
    const float s0 = sconv_l[((size_t)b * 3 + 0) * 1024 + c], s1 = sconv_l[((size_t)b * 3 + 1) * 1024 + c], s2 = sconv_l[((size_t)b * 3 + 2) * 1024 + c];
    const float xc = P.cb[c] + P.cw[c] * s0 + P.cw[1024 + c] * s1 + P.cw[2048 + c] * s2 + P.cw[3072 + c] * xn;
    float rpre = P.ba[c], ipre = P.bx[c];
#pragma unroll 32
    for (int i = 0; i < 64; ++i) { const float xi = __shfl(xc, i); rpre += xi * P.wa[((size_t)blk * 64 + i) * 64 + lane]; ipre += xi * P.wx[((size_t)blk * 64 + i) * 64 + lane]; }
    const float nsp = -8.f * LOG2E * log1pf(__expf(-P.lam[c]));
    float av, uv; lru_gate(rpre, ipre, xc, nsp, av, uv);
    const float h = av * sh_l[(size_t)b * 1024 + c] + uv;
    zo[row * 1024 + c] = f2bf(h * bf2f(zya[row * 1024 + c]));
    oconv_l[((size_t)b * 3 + 0) * 1024 + c] = s1; oconv_l[((size_t)b * 3 + 1) * 1024 + c] = s2; oconv_l[((size_t)b * 3 + 2) * 1024 + c] = xn;
    oh_l[(size_t)b * 1024 + c] = h;
}

DI void swa_item(const int tid, unsigned char* lds, int b, int kvh, int qb, const bf16_t* zkv, const bf16_t* vt, const bf16_t* zqs, bf16_t* zo, const float* sinks_l) {
    const int lane = tid & 63, w = tid >> 6, fr = lane & 15, fq = lane >> 4;
    bf16_t* Ks = (bf16_t*)lds;
    bf16_t* Vs = (bf16_t*)(lds + 36864);
#pragma unroll
    for (int i = 0; i < 4; ++i) { const int ch = tid + 512 * i;
        { const int r = ch >> 3, c8 = ch & 7; const int tok = (qb == 0 && r < 128) ? r : 128 * (qb - 1) + r;
          *(u32x4*)&Ks[r * 72 + c8 * 8] = *(const u32x4*)&zkv[((size_t)b * SEQ + tok) * 512 + kvh * 64 + c8 * 8]; }
        { const int d = ch >> 5, rem = ch & 31, half = rem >> 4, c16 = rem & 15; const int tokbase = half ? 128 * qb : (qb == 0 ? 0 : 128 * (qb - 1));
          *(u32x4*)&Vs[d * 272 + half * 128 + c16 * 8] = *(const u32x4*)&vt[(size_t)(kvh * 64 + d) * MT + (size_t)b * SEQ + tokbase + c16 * 8]; }
    }
    __syncthreads();
    const int head = kvh * 4 + (w >> 1), qh = w & 1; const float sink = sinks_l[head] * LOG2E;
    for (int p = 0; p < 2; ++p) {
        const int q0 = 64 * qh + 32 * p, kt0 = q0 >> 4; const size_t rowq = (size_t)b * SEQ + 128 * qb + q0;
        bf16x8 Qf[2][2];
#pragma unroll
        for (int qt = 0; qt < 2; ++qt)
#pragma unroll
            for (int ks = 0; ks < 2; ++ks) Qf[qt][ks] = *(const bf16x8*)&zqs[(rowq + 16 * qt + fr) * 1024 + head * 64 + 32 * ks + 8 * fq];
        f32x4 S[10][2];
#pragma unroll
        for (int i = 0; i < 10; ++i) {
            const bf16x8 K0 = *(const bf16x8*)&Ks[(16 * (kt0 + i) + fr) * 72 + 8 * fq], K1 = *(const bf16x8*)&Ks[(16 * (kt0 + i) + fr) * 72 + 32 + 8 * fq];
#pragma unroll
            for (int qt = 0; qt < 2; ++qt) { S[i][qt] = __builtin_amdgcn_mfma_f32_16x16x32_bf16(K0, Qf[qt][0], (f32x4){0.f, 0.f, 0.f, 0.f}, 0, 0, 0); S[i][qt] = __builtin_amdgcn_mfma_f32_16x16x32_bf16(K1, Qf[qt][1], S[i][qt], 0, 0, 0); }
        }
        float den[2];
#pragma unroll
        for (int qt = 0; qt < 2; ++qt) {
            const int jq = q0 + 16 * qt + fr; float mx = -1e30f;
#pragma unroll
            for (int i = 0; i < 10; ++i)
#pragma unroll
                for (int j = 0; j < 4; ++j) { const int m = 16 * (kt0 + i) + 4 * fq + j; const bool valid = (m > jq) && (m <= jq + 128) && (qb > 0 || m >= 128);
                    const float s = valid ? S[i][qt][j] : -1e30f; S[i][qt][j] = s; mx = fmaxf(mx, s); }
            mx = fmaxf(mx, __shfl_xor(mx, 16)); mx = fmaxf(mx, __shfl_xor(mx, 32)); mx = fmaxf(mx, sink);
            float sum = 0.f;
#pragma unroll
            for (int i = 0; i < 10; ++i)
#pragma unroll
                for (int j = 0; j < 4; ++j) { const float e = fexp2(S[i][qt][j] - mx); S[i][qt][j] = e; sum += e; }
            sum += __shfl_xor(sum, 16); sum += __shfl_xor(sum, 32);
            den[qt] = sum + fexp2(sink - mx);
        }
        f32x4 O[4][2];
#pragma unroll
        for (int dt = 0; dt < 4; ++dt) { O[dt][0] = (f32x4){0.f, 0.f, 0.f, 0.f}; O[dt][1] = (f32x4){0.f, 0.f, 0.f, 0.f}; }
#pragma unroll
        for (int ii = 0; ii < 5; ++ii) {
            bf16x8 Pf[2];
#pragma unroll
            for (int qt = 0; qt < 2; ++qt) { u32x4 pw; pw.x = pk2(S[2 * ii][qt][0], S[2 * ii][qt][1]); pw.y = pk2(S[2 * ii][qt][2], S[2 * ii][qt][3]); pw.z = pk2(S[2 * ii + 1][qt][0], S[2 * ii + 1][qt][1]); pw.w = pk2(S[2 * ii + 1][qt][2], S[2 * ii + 1][qt][3]); Pf[qt] = __builtin_bit_cast(bf16x8, pw); }
#pragma unroll
            for (int dt = 0; dt < 4; ++dt) {
                const s16x4 lo = *(const s16x4*)&Vs[(16 * dt + fr) * 272 + 16 * (kt0 + 2 * ii) + 4 * fq], hi = *(const s16x4*)&Vs[(16 * dt + fr) * 272 + 16 * (kt0 + 2 * ii) + 16 + 4 * fq];
                const bf16x8 Vf = {lo[0], lo[1], lo[2], lo[3], hi[0], hi[1], hi[2], hi[3]};
#pragma unroll
                for (int qt = 0; qt < 2; ++qt) O[dt][qt] = __builtin_amdgcn_mfma_f32_16x16x32_bf16(Vf, Pf[qt], O[dt][qt], 0, 0, 0);
            }
        }
#pragma unroll
        for (int qt = 0; qt < 2; ++qt) { const float inv = 1.f / den[qt];
#pragma unroll
            for (int dt = 0; dt < 4; ++dt) st_bf4(&zo[(rowq + 16 * qt + fr) * 1024 + head * 64 + 16 * dt + 4 * fq], O[dt][qt] * inv); }
    }
    __syncthreads();
}
DI void swa_sample(int b, int head, int lane, const float* cwk_l, const float* cwv_l, const float* newk_l, const float* newv_l, const bf16_t* zqs, bf16_t* zo, const float* sinks_l) {
    const int kvh = head >> 2; const size_t row = (size_t)MPR + b;
    const float qv = bf2f(zqs[row * 1024 + head * 64 + lane]);
    float s[2];
#pragma unroll
    for (int hh = 0; hh < 2; ++hh) { const int j = lane + 64 * hh;
        const float* kp = (j < 127) ? cwk_l + ((size_t)(b * 128 + j + 1) * 4 + kvh) * 64 : newk_l + ((size_t)(b * 128 + 127) * 4 + kvh) * 64;
        float acc = 0.f;
#pragma unroll
        for (int d4 = 0; d4 < 16; ++d4) { const f32x4 kv = *(const f32x4*)(kp + 4 * d4);
            acc += __shfl(qv, 4 * d4) * kv[0] + __shfl(qv, 4 * d4 + 1) * kv[1] + __shfl(qv, 4 * d4 + 2) * kv[2] + __shfl(qv, 4 * d4 + 3) * kv[3]; }
        s[hh] = acc; }
    const float sink = sinks_l[head] * LOG2E;
    const float mx = fmaxf(wave_max(fmaxf(s[0], s[1])), sink);
    const float e0 = fexp2(s[0] - mx), e1 = fexp2(s[1] - mx);
    const float den = wave_sum(e0 + e1) + fexp2(sink - mx);
    float o = 0.f;
#pragma unroll 32
    for (int j = 0; j < 128; ++j) { const float pj = __shfl((j < 64) ? e0 : e1, j & 63);
        const float* vp = (j < 127) ? cwv_l + ((size_t)(b * 128 + j + 1) * 4 + kvh) * 64 : newv_l + ((size_t)(b * 128 + 127) * 4 + kvh) * 64;
        o += pj * vp[lane]; }
    zo[row * 1024 + head * 64 + lane] = f2bf(o / den);
}

DI void mem_item(const int tid, unsigned char* lds, int b, int h, int q8, const bf16_t* mkb_l, const bf16_t* mvt_l, const bf16_t* zxc, bf16_t* zo) {
    const int lane = tid & 63, w = tid >> 6, fr = lane & 15, fq = lane >> 4;
    bf16_t* Km = (bf16_t*)lds;
#pragma unroll
    for (int i = 0; i < 16; ++i) { const int ch = tid + 512 * i, r = ch >> 5, c16 = ch & 31;
        *(u32x4*)&Km[r * 264 + c16 * 8] = *(const u32x4*)&mkb_l[((size_t)b * 256 + r) * 1024 + h * 256 + c16 * 8]; }
    const size_t row = (size_t)b * SEQ + 128 * q8 + 16 * w + fr;
    bf16x8 Qf[8];
#pragma unroll
    for (int ks = 0; ks < 8; ++ks) Qf[ks] = *(const bf16x8*)&zxc[row * 1024 + h * 256 + 32 * ks + 8 * fq];
    __syncthreads();
    f32x4 S[16];
#pragma unroll
    for (int kt = 0; kt < 16; ++kt) { f32x4 acc = {0.f, 0.f, 0.f, 0.f};
#pragma unroll
        for (int ks = 0; ks < 8; ++ks) { const bf16x8 Kf = *(const bf16x8*)&Km[(16 * kt + fr) * 264 + 32 * ks + 8 * fq]; acc = __builtin_amdgcn_mfma_f32_16x16x32_bf16(Kf, Qf[ks], acc, 0, 0, 0); }
        S[kt] = acc; }
    float mx = -1e30f;
#pragma unroll
    for (int kt = 0; kt < 16; ++kt) mx = fmaxf(fmaxf(mx, fmaxf(S[kt][0], S[kt][1])), fmaxf(S[kt][2], S[kt][3]));
    mx = fmaxf(mx, __shfl_xor(mx, 16)); mx = fmaxf(mx, __shfl_xor(mx, 32));
    float sum = 0.f; bf16x8 Pf[8];
#pragma unroll
    for (int ii = 0; ii < 8; ++ii) { f32x4 e0, e1;
#pragma unroll
        for (int j = 0; j < 4; ++j) { e0[j] = fexp2(S[2 * ii][j] - mx); e1[j] = fexp2(S[2 * ii + 1][j] - mx); }
        sum += (e0[0] + e0[1]) + (e0[2] + e0[3]) + (e1[0] + e1[1]) + (e1[2] + e1[3]);
        u32x4 pw; pw.x = pk2(e0[0], e0[1]); pw.y = pk2(e0[2], e0[3]); pw.z = pk2(e1[0], e1[1]); pw.w = pk2(e1[2], e1[3]); Pf[ii] = __builtin_bit_cast(bf16x8, pw); }
    sum += __shfl_xor(sum, 16); sum += __shfl_xor(sum, 32);
    __syncthreads();
    bf16_t* Vm = (bf16_t*)lds;
#pragma unroll
    for (int i = 0; i < 16; ++i) { const int ch = tid + 512 * i, r = ch >> 5, c16 = ch & 31;
        *(u32x4*)&Vm[r * 272 + c16 * 8] = *(const u32x4*)&mvt_l[((size_t)h * 256 + r) * 4096 + (size_t)b * 256 + c16 * 8]; }
    __syncthreads();
    const float inv = 1.f / sum;
#pragma unroll
    for (int dt = 0; dt < 16; ++dt) { f32x4 acc = {0.f, 0.f, 0.f, 0.f};
#pragma unroll
        for (int ii = 0; ii < 8; ++ii) { const s16x4 lo = *(const s16x4*)&Vm[(16 * dt + fr) * 272 + 32 * ii + 4 * fq], hi = *(const s16x4*)&Vm[(16 * dt + fr) * 272 + 32 * ii + 16 + 4 * fq];
            const bf16x8 Vf = {lo[0], lo[1], lo[2], lo[3], hi[0], hi[1], hi[2], hi[3]}; acc = __builtin_amdgcn_mfma_f32_16x16x32_bf16(Vf, Pf[ii], acc, 0, 0, 0); }
        st_bf4(&zo[row * 1024 + h * 256 + 16 * dt + 4 * fq], acc * inv); }
    __syncthreads();
}
DI void mem_sample(const int tid, unsigned char* lds, int b, int h, const float* cmk_l, const float* cmv_l, const bf16_t* zxc, bf16_t* zo) {
    const int lane = tid & 63, w = tid >> 6; const size_t row = (size_t)MPR + b;
    float* sc = (float*)lds;
    float* po = (float*)lds + 256;
    f32x4 q; { const u32x2 qq = *(const u32x2*)&zxc[row * 1024 + h * 256 + 4 * lane]; q[0] = bflo(qq.x); q[1] = bfhi(qq.x); q[2] = bflo(qq.y); q[3] = bfhi(qq.y); }
    const float* kb = cmk_l + (((size_t)b * 256 + 32 * w) * 4 + h) * 256 + 4 * lane;
#pragma unroll 16
    for (int kk = 0; kk < 32; ++kk) { const f32x4 kv = *(const f32x4*)(kb + (size_t)kk * 1024); float d = (q[0] * kv[0] + q[1] * kv[1]) + (q[2] * kv[2] + q[3] * kv[3]); d = wave_sum(d); if (lane == 0) sc[32 * w + kk] = d; }
    __syncthreads();
    const f32x4 sv = *(const f32x4*)&sc[4 * lane];
    const float mx = wave_max(fmaxf(fmaxf(sv[0], sv[1]), fmaxf(sv[2], sv[3])));
    const float sum = wave_sum((fexp2(sv[0] - mx) + fexp2(sv[1] - mx)) + (fexp2(sv[2] - mx) + fexp2(sv[3] - mx)));
    const float inv = 1.f / sum;
    const float* vb = cmv_l + (((size_t)b * 256 + 32 * w) * 4 + h) * 256 + 4 * lane;
    f32x4 o = {0.f, 0.f, 0.f, 0.f};
#pragma unroll 16
    for (int kk = 0; kk < 32; ++kk) { const float p = fexp2(sc[32 * w + kk] - mx) * inv; const f32x4 vv = *(const f32x4*)(vb + (size_t)kk * 1024); o += vv * p; }
    *(f32x4*)&po[w * 256 + 4 * lane] = o;
    __syncthreads();
    if (tid < 256) { float s = 0.f;
#pragma unroll
        for (int ww = 0; ww < 8; ++ww) s += po[ww * 256 + tid];
        zo[row * 1024 + h * 256 + tid] = f2bf(s); }
    __syncthreads();
}

#ifndef REP_PRO
#define REP_PRO 1
#endif
#ifndef REP_SMP
#define REP_SMP 1
#endif
#ifndef REP_LRU
#define REP_LRU 1
#endif
#ifndef REP_SWA
#define REP_SWA 1
#endif
#ifndef REP_MEM
#define REP_MEM 1
#endif
#ifndef REP_GEMM
#define REP_GEMM 1
#endif
#ifndef REP_LN
#define REP_LN 1
#endif
#define REOPQ asm volatile("" : "+s"(ws), "+s"(out), "+s"(G), "+s"(bid), "+s"(l), "+v"(tid));
#define REPGN(R, ...) { __VA_ARGS__ } if (REP_GEMM > 1 || (R) > 1) { REOPQ __VA_ARGS__ }
#ifndef REP_G1
#define REP_G1 1
#endif
#ifndef REP_G2
#define REP_G2 1
#endif
#ifndef REP_G3
#define REP_G3 1
#endif
#ifndef REP_G4
#define REP_G4 1
#endif
#ifndef REP_G5
#define REP_G5 1
#endif
#define REPL(...) { __VA_ARGS__ } if (REP_LN > 1) { REOPQ __VA_ARGS__ }
#define PHASE_BEGIN if (a.coop || (ph >= a.ph_lo && ph < a.ph_hi)) { unsigned char* ws = a.ws; float* out = a.out; int G = gridDim.x, bid = blockIdx.x, l = l0, tid = wave_s * 64 + (int)__builtin_amdgcn_mbcnt_hi(~0u, __builtin_amdgcn_mbcnt_lo(~0u, 0u)); \
        asm volatile("" : "+s"(ws), "+s"(out), "+s"(G), "+s"(bid), "+s"(l), "+v"(tid)); const int lane = tid & 63, wave = tid >> 6; (void)lane; const int gw = bid * 8 + wave, NGW = G * 8; (void)gw; (void)NGW; (void)out; (void)l;
#define PHASE_END } ++ph; if (a.coop) { int tid_ = wave_s * 64 + (int)__builtin_amdgcn_mbcnt_hi(~0u, __builtin_amdgcn_mbcnt_lo(~0u, 0u)); xcd_barrier((unsigned*)(a.ws + WS_CTL) + 4096, (volatile LAS unsigned*)((LAS unsigned char*)lds + MISC_OFF), tid_); }
#define RB_ ((bf16_t*)(ws + WS_RB))
#define RF_ ((float*)(ws + WS_RF))
#define ZYA_ ((bf16_t*)(ws + WS_ZYA))
#define ZQS_ ((bf16_t*)(ws + WS_ZQS))
#define ZXC_ ((bf16_t*)(ws + WS_ZXC))
#define ZXR_ ((bf16_t*)(ws + WS_ZXR))
#define ZKV_ ((bf16_t*)(ws + WS_ZKV))
#define GT_ ((bf16_t*)(ws + WS_GT))
#define MG_ ((bf16_t*)(ws + WS_MG))
#define VT_ ((bf16_t*)(ws + WS_VT))
#define HID_ ((bf16_t*)(ws + WS_ZYA))
#define MPB_ ((bf16_t*)(ws + WS_MPB))
#define Y_ ((float*)(ws + WS_GT))

template <int l0> DI void layer_phases(const Args& a, unsigned char* lds, const int wave_s, int& ph, cg::grid_group& grid) {
    LAS unsigned char* ldsl = (LAS unsigned char*)lds;
        PHASE_BEGIN
        REPGN(REP_G1,
            const bf16_t* WIN = (const bf16_t*)(ws + WS_WIN) + (size_t)l * INC * DM;
            {
            EpiIn E{ws, out, a.in[I_BG] + (size_t)l * 3072, l};
            GridSched S; S.init(128, 30, G, bid, 0, 0);
            gemm_phase(tid, ldsl, RB_, WIN, DM, S, E);
            { const int fr = lane & 15, fq = lane >> 4;
              SKINNY_UNITS(8 * 240) { const int rg = wu & 7, cu = wu >> 3, row = MPR + 16 * rg + fr; f32x4 acc[2] = {{0.f, 0.f, 0.f, 0.f}, {0.f, 0.f, 0.f, 0.f}};
                skinny_mm<2, 8>(RB_ + (size_t)row * 1024 + 8 * fq, WIN + (size_t)(32 * cu + fr) * 1024 + 8 * fq, WIN + (size_t)(32 * cu + 16 + fr) * 1024 + 8 * fq, DM, acc);
                E.apply(row, (32 * cu) >> 8, ((32 * cu) & 255) + 4 * fq, acc[0]); E.apply(row, (32 * cu) >> 8, ((32 * cu) & 255) + 16 + 4 * fq, acc[1]); } }
            }
            { EpiPlain ET{VT_, MT}; GridSched S2; S2.init(1, 128, G, bid, 13, 0);
            gemm_phase(tid, ldsl, WIN, RB_, DM, S2, ET); }
            if (l == 0) {
                for (int l2 = 0; l2 < 2; ++l2) {
                    const bf16_t* WMK = (const bf16_t*)(ws + WS_WMKV) + (size_t)l2 * 2048 * DM;
                    { EpiMem EM{out + O_PMK + (size_t)l2 * 4096 * 1024, out + O_PMV + (size_t)l2 * 4096 * 1024, (bf16_t*)(ws + WS_MKB) + (size_t)l2 * 4096 * DM};
                    GridSched S3; S3.init(16, 8, G, (bid + 128 + 192 * l2) % G, 0, 0);
                    gemm_phase(tid, ldsl, MPB_, WMK, DM, S3, EM); }
                    { EpiPlain EV{(bf16_t*)(ws + WS_MVT) + (size_t)l2 * 4096 * DM, 4096}; GridSched S4; S4.init(4, 16, G, (bid + 192 * l2) % G, 4, 0);
                    gemm_phase(tid, ldsl, WMK, MPB_, DM, S4, EV); }
                }
            }
        )
        PHASE_END
        PHASE_BEGIN
        {
            const LruP LP{a.in[I_CW] + (size_t)l * 4096, a.in[I_CB] + (size_t)l * 1024, a.in[I_WA] + (size_t)l * 65536, a.in[I_BA] + (size_t)l * 1024, a.in[I_WX] + (size_t)l * 65536, a.in[I_BX] + (size_t)l * 1024, a.in[I_LAM] + (size_t)l * 1024};
            const float* sinks_l = a.in[I_SINK] + l * 16;
#define MIX_SMP(ZA, ZQ, ZC) \
            for (int it = bid; it < 512; it += G) mem_sample(tid, lds, it >> 2, it & 3, a.in[I_CMK] + (size_t)l * 128 * 256 * 1024, a.in[I_CMV] + (size_t)l * 128 * 256 * 1024, ZXC_, ZC); \
            for (int it = gw; it < 2048; it += NGW) lru_sample(it >> 4, it & 15, lane, LP, ZXR_, ZYA_, ZA, a.in[I_SCONV] + (size_t)l * 128 * 3 * 1024, a.in[I_SH] + (size_t)l * 128 * 1024, out + O_SCONV + (size_t)l * 128 * 3 * 1024, out + O_SH + (size_t)l * 128 * 1024); \
            for (int it = gw; it < 2048; it += NGW) swa_sample(it >> 4, it & 15, lane, a.in[I_CWK] + (size_t)l * 128 * 128 * 256, a.in[I_CWV] + (size_t)l * 128 * 128 * 256, out + O_SWK + (size_t)l * 128 * 128 * 256, out + O_SWV + (size_t)l * 128 * 128 * 256, ZQS_, ZQ, sinks_l); \
            for (int i = gw * 64 + lane; i < 2 * 128 * 127 * 64; i += NGW * 64) { const int which = i / (128 * 127 * 64), r = i % (128 * 127 * 64), bb = r / (127 * 64), rr = r % (127 * 64), j = rr >> 6, c4 = (rr & 63) * 4; \
                const float* src = (which ? a.in[I_CWV] : a.in[I_CWK]) + (size_t)l * 128 * 128 * 256 + ((size_t)bb * 128 + j + 1) * 256 + c4; \
                float* dst = out + (which ? O_SWV : O_SWK) + (size_t)l * 128 * 128 * 256 + ((size_t)bb * 128 + j) * 256 + c4; *(f32x4*)dst = *(const f32x4*)src; } \
            __syncthreads();
#define MIX_LRU(ZA) for (int it = bid; it < 256; it += G) lru_item(tid, lds, it >> 4, it & 15, LP, ZXR_, ZYA_, ZA, out + O_PCONV + (size_t)l * 16 * 3 * 1024, out + O_PH + (size_t)l * 16 * 1024);
#define MIX_SWA(ZQ) for (int it = bid; it < 1024; it += G) swa_item(tid, lds, it >> 6, (it >> 4) & 3, it & 15, ZKV_, VT_, ZQS_, ZQ, sinks_l);
#define MIX_MEM(ZC) for (int it = bid; it < 1024; it += G) mem_item(tid, lds, it >> 6, (it >> 4) & 3, it & 15, (const bf16_t*)(ws + WS_MKB) + (size_t)l * 4096 * DM, (const bf16_t*)(ws + WS_MVT) + (size_t)l * 4096 * DM, ZXC_, ZC);
            if (REP_SMP > 1) { MIX_SMP(MG_, MG_, MG_) }
            MIX_SMP(ZYA_, ZQS_, ZXC_)
            if (REP_LRU > 1) { MIX_LRU(MG_) }
            MIX_LRU(ZYA_)
            if (REP_SWA > 1) { MIX_SWA(MG_) }
            MIX_SWA(ZQS_)
            if (REP_MEM > 1) { MIX_MEM(MG_) }
            MIX_MEM(ZXC_)
        }
        PHASE_END
        PHASE_BEGIN
        REPGN(REP_G2, EpiBranch E{GT_, MG_}; BranchSched S{G, bid}; gemm_phase(tid, ldsl, ZYA_, (const bf16_t*)(ws + WS_WBR) + (size_t)l * 3072 * DM, DM, S, E);
          { const int fr = lane & 15, fq = lane >> 4; const bf16_t* WB = (const bf16_t*)(ws + WS_WBR) + (size_t)l * 3072 * DM;
            SKINNY_UNITS(8 * 64) { const int rg = wu & 7, cu = wu >> 3, row = MPR + 16 * rg + fr; f32x4 mg = {0.f, 0.f, 0.f, 0.f};
              _Pragma("unroll 1") for (int nb = 0; nb < 3; ++nb) { f32x4 acc[1] = {{0.f, 0.f, 0.f, 0.f}};
                skinny_mm<1, 16>(ZYA_ + (size_t)nb * MT * 1024 + (size_t)row * 1024 + 8 * fq, WB + (size_t)(nb * 1024 + 16 * cu + fr) * 1024 + 8 * fq, nullptr, DM, acc);
                const u32x2 g = *(const u32x2*)(GT_ + (size_t)row * 3072 + nb * 1024 + 16 * cu + 4 * fq);
                mg[0] += bflo(g.x) * acc[0][0]; mg[1] += bfhi(g.x) * acc[0][1]; mg[2] += bflo(g.y) * acc[0][2]; mg[3] += bfhi(g.y) * acc[0][3]; }
              st_bf4(MG_ + (size_t)row * 1024 + 16 * cu + 4 * fq, mg); } } )
        PHASE_END
        PHASE_BEGIN
        REPGN(REP_G3, EpiRes E{l == 0 ? a.in[I_XP] : RF_, l == 0 ? a.in[I_XS] : RF_ + (size_t)MPR * 1024, Y_}; GridSched S; S.init(128, 4, G, bid, 0, 0); gemm_phase(tid, ldsl, MG_, (const bf16_t*)(ws + WS_WOUT) + (size_t)l * DM * DM, DM, S, E);
          { const int fr = lane & 15, fq = lane >> 4; const bf16_t* WO = (const bf16_t*)(ws + WS_WOUT) + (size_t)l * DM * DM;
            SKINNY_UNITS(8 * 64) { const int rg = wu & 7, cu = wu >> 3, row = MPR + 16 * rg + fr; f32x4 acc[1] = {{0.f, 0.f, 0.f, 0.f}};
              skinny_mm<1, 16>(MG_ + (size_t)row * 1024 + 8 * fq, WO + (size_t)(16 * cu + fr) * 1024 + 8 * fq, nullptr, DM, acc);
              E.apply(row, (16 * cu) >> 8, ((16 * cu) & 255) + 4 * fq, acc[0]); } } )
        PHASE_END
        PHASE_BEGIN REPL(ln_phase(Y_, a.in[I_L1G] + l * 1024, a.in[I_L1B] + l * 1024, RF_, RB_, gw, NGW, lane);) PHASE_END
        PHASE_BEGIN
        REPGN(REP_G4, EpiGLU E{HID_}; GridSched S; S.init(128, 22, G, bid, 0, 0); gemm_phase(tid, ldsl, RB_, (const bf16_t*)(ws + WS_WGU) + (size_t)l * 2 * DFF * DM, DM, S, E);
          { const int fr = lane & 15, fq = lane >> 4; const bf16_t* WG = (const bf16_t*)(ws + WS_WGU) + (size_t)l * 2 * DFF * DM;
            SKINNY_UNITS(8 * 176) { const int rg = wu & 7, cu = wu >> 3, pn = cu >> 3, g16 = cu & 7, row = MPR + 16 * rg + fr; f32x4 acc[2] = {{0.f, 0.f, 0.f, 0.f}, {0.f, 0.f, 0.f, 0.f}};
              skinny_mm<2, 8>(RB_ + (size_t)row * 1024 + 8 * fq, WG + (size_t)(pn * 256 + 16 * g16 + fr) * 1024 + 8 * fq, WG + (size_t)(pn * 256 + 128 + 16 * g16 + fr) * 1024 + 8 * fq, DM, acc);
              E.apply(row, pn, 16 * g16 + 4 * fq, acc[0], acc[1]); } } )
        PHASE_END
        PHASE_BEGIN
        REPGN(REP_G5, EpiRes E{RF_, RF_ + (size_t)MPR * 1024, Y_}; GridSched S; S.init(128, 4, G, bid, 0, 0); gemm_phase(tid, ldsl, HID_, (const bf16_t*)(ws + WS_WDN) + (size_t)l * DM * DFF, DFF, S, E);
          { const int fr = lane & 15, fq = lane >> 4; const bf16_t* WD = (const bf16_t*)(ws + WS_WDN) + (size_t)l * DM * DFF;
            SKINNY_UNITS(8 * 64) { const int rg = wu & 7, cu = wu >> 3, row = MPR + 16 * rg + fr; f32x4 acc[1] = {{0.f, 0.f, 0.f, 0.f}};
              skinny_mm<1, 11>(HID_ + (size_t)row * DFF + 8 * fq, WD + (size_t)(16 * cu + fr) * DFF + 8 * fq, nullptr, DFF, acc);
              E.apply(row, (16 * cu) >> 8, ((16 * cu) & 255) + 4 * fq, acc[0]); } } )
        PHASE_END
        PHASE_BEGIN REPL(ln_phase(Y_, a.in[I_L2G] + l * 1024, a.in[I_L2B] + l * 1024, l == 1 ? out : RF_, RB_, gw, NGW, lane);) PHASE_END
    }

__global__ void __launch_bounds__(512, 2) fwd_kernel(Args a) {
    extern __shared__ __attribute__((aligned(16))) unsigned char lds[];
    cg::grid_group grid = cg::this_grid();
    LAS unsigned char* ldsl = (LAS unsigned char*)lds;
    int ph = 0;
    if (threadIdx.x < 2) ((LAS unsigned*)((LAS unsigned char*)lds + MISC_OFF))[threadIdx.x] = 0u;
    if (a.coop && threadIdx.x == 0) (void)xb_add((unsigned*)(a.ws + WS_CTL) + 4096 + XB_XCNT(xb_xcc_id()), 1u);
    __syncthreads();
    int wave_s = __builtin_amdgcn_readfirstlane((int)threadIdx.x >> 6); asm volatile("" : "+s"(wave_s));
    { const int l0 = 0;
    PHASE_BEGIN
prologue(a, lds, gw, NGW, lane, wave); if (REP_PRO > 1) { __syncthreads(); prologue(a, lds, gw, NGW, lane, wave); }
    } ++ph; if (a.coop) grid.sync();
    }
    layer_phases<0>(a, lds, wave_s, ph, grid);
    layer_phases<1>(a, lds, wave_s, ph, grid);
}

constexpr int N_PHASES = 17;
#ifndef ONE_LAUNCH
#define ONE_LAUNCH 1
#endif
extern "C" void kernel_launch(void* const* d_in, const int* in_sizes, int n_in, void* d_out, int out_size, void* d_ws, size_t ws_size, hipStream_t stream) {
    constexpr int LDS_BYTES = 143360;
    static int grid = 0;
    if (grid == 0) {
        if (n_in != 28 || (size_t)out_size != O_END || ws_size < WS_END) { fprintf(stderr, "kernel_launch: unexpected sizes n_in %d out %d ws %zu (need %zu)\n", n_in, out_size, ws_size, (size_t)WS_END); grid = -1; return; }
        int dev = 0, cus = 0, per_cu = 0;
        (void)hipGetDevice(&dev);
        (void)hipDeviceGetAttribute(&cus, hipDeviceAttributeMultiprocessorCount, dev);
        (void)hipFuncSetAttribute((const void*)fwd_kernel, hipFuncAttributeMaxDynamicSharedMemorySize, LDS_BYTES);
        (void)hipOccupancyMaxActiveBlocksPerMultiprocessor(&per_cu, (const void*)fwd_kernel, 512, LDS_BYTES);
        if (per_cu < 1) per_cu = 1;
        grid = cus * per_cu;
        fprintf(stderr, "kernel_launch: grid %d (cus %d x %d), ws %zu need %zu\n", grid, cus, per_cu, ws_size, (size_t)WS_END);
    }
    if (grid < 0) return;
    (void)hipMemsetAsync((char*)d_ws + WS_CTL, 0, 65536, stream);
    Args a{};
    for (int i = 0; i < 28; ++i) a.in[i] = (const float*)d_in[i];
    a.out = (float*)d_out; a.ws = (unsigned char*)d_ws;
#if ONE_LAUNCH
    a.coop = 1; a.ph_lo = 0; a.ph_hi = N_PHASES;
    void* args[] = {&a};
    hipError_t e = hipLaunchCooperativeKernel((const void*)fwd_kernel, dim3(grid), dim3(512), args, LDS_BYTES, stream);
    if (e != hipSuccess) fprintf(stderr, "cooperative launch failed: %s (grid %d)\n", hipGetErrorString(e), grid);
#else
    a.coop = 0;
    for (int p = 0; p < N_PHASES; ++p) { a.ph_lo = p; a.ph_hi = p + 1; hipLaunchKernelGGL(fwd_kernel, dim3(grid), dim3(512), LDS_BYTES, stream, a); }
#endif
}
```
